# Optimizing an MI355X kernel written in HIP

```python
import numpy as np
import jax
import jax.numpy as jnp
from jax import lax

D_MODEL = 2048
BATCH = 4
SEQ = 4096
DEPTH = 2

GRID_W = 64
CTX_LEN = 256
Q_BLOCK = 128
ROPE_THETA = 10000.0
EPS = 1e-6

GQA_HEADS = 8
GQA_KV_HEADS = 2
GQA_GROUP = GQA_HEADS // GQA_KV_HEADS
HEAD_DIM = 128
CONV_DIM = 1024
CONV_WIDTH = 3
MLA_HEADS = 8
MLA_Q_LORA = 512
MLA_KV_LORA = 256
MLA_NOPE = 128
MLA_ROPE = 64
MLA_V = 128
MLA_QK = MLA_NOPE + MLA_ROPE
N_BRANCH = 3
COL_SIZES = (GQA_KV_HEADS * HEAD_DIM, GQA_KV_HEADS * HEAD_DIM, MLA_KV_LORA, MLA_ROPE,
             GQA_HEADS * HEAD_DIM, MLA_Q_LORA,
             CONV_DIM, CONV_DIM, CONV_DIM, N_BRANCH * D_MODEL)
KV_COLS = sum(COL_SIZES[:4])
REST_OFF = sum(COL_SIZES[:6])
IN_COLS = sum(COL_SIZES)
N_GROUPS = 4
EXPERTS_PER_GROUP = 8
N_EXPERTS = N_GROUPS * EXPERTS_PER_GROUP
TOP_K = 2
D_EXPERT = 512
MOE_BLOCK = 256

kernel_name = 'hybrid_gqa_conv_mla_hmoe_dit'


def rms_norm(x, g):
    xf = x.astype(jnp.float32)
    y = xf * lax.rsqrt(jnp.mean(xf * xf, axis=-1, keepdims=True) + EPS)
    return (y * g.astype(jnp.float32)).astype(x.dtype)


def split_cols(p, sizes):
    offs = np.cumsum((0,) + tuple(sizes))
    return [p[..., int(a):int(b)] for a, b in zip(offs[:-1], offs[1:])]


def rope_tables(rows, cols, rot_dim):
    n = rot_dim // 4
    inv = ROPE_THETA ** (-jnp.arange(n, dtype=jnp.float32) / n)
    ang = jnp.concatenate([rows[:, None] * inv, cols[:, None] * inv], axis=-1)
    return jnp.cos(ang), jnp.sin(ang)


def apply_rope(x, cos, sin):
    shape = (1, x.shape[1]) + (1,) * (x.ndim - 3) + (cos.shape[-1],)
    cs = cos.reshape(shape).astype(x.dtype)
    sn = sin.reshape(shape).astype(x.dtype)
    half = x.shape[-1] // 2
    x1, x2 = x[..., :half], x[..., half:]
    return jnp.concatenate([x1 * cs - x2 * sn, x2 * cs + x1 * sn], axis=-1)


def rope_tail(x, cos, sin):
    return jnp.concatenate([x[..., :MLA_NOPE], apply_rope(x[..., MLA_NOPE:], cos, sin)], axis=-1)


def blocked_attention(q, k, v):
    b, sq, hk, g, dk = q.shape
    nb = sq // Q_BLOCK
    scale = dk ** -0.5
    qb = jnp.moveaxis(q.reshape(b, nb, Q_BLOCK, hk, g, dk), 1, 0)

    def one_block(qi):
        s = jnp.einsum('bqhgd,bkhd->bhgqk', qi, k, preferred_element_type=jnp.float32) * scale
        pr = jax.nn.softmax(s, axis=-1).astype(v.dtype)
        return jnp.einsum('bhgqk,bkhd->bqhgd', pr, v)

    o = lax.map(one_block, qb)
    return jnp.moveaxis(o, 0, 1).reshape(b, sq, hk * g * v.shape[-1])


def attn_keys(p_kv, gqa_k_norm, mla_kv_lora_norm, w_ukv, mla_k_norm):
    ka, va, ckv, krope = split_cols(p_kv, COL_SIZES[:4])
    lead = p_kv.shape[:-1]
    ka = rms_norm(ka.reshape(lead + (GQA_KV_HEADS, HEAD_DIM)), gqa_k_norm)
    va = va.reshape(lead + (GQA_KV_HEADS, HEAD_DIM))
    kv = (rms_norm(ckv, mla_kv_lora_norm) @ w_ukv).reshape(lead + (MLA_HEADS, MLA_NOPE + MLA_V))
    k_nope, vc = kv[..., :MLA_NOPE], kv[..., MLA_NOPE:]
    krope_h = jnp.broadcast_to(krope[..., None, :], lead + (MLA_HEADS, MLA_ROPE))
    kc = rms_norm(jnp.concatenate([k_nope, krope_h], axis=-1), mla_k_norm)
    return ka, va, kc, vc


def attn_queries(p_q, gqa_q_norm, mla_q_lora_norm, w_uq, mla_q_norm):
    qa, cq = split_cols(p_q, COL_SIZES[4:6])
    lead = p_q.shape[:-1]
    qa = rms_norm(qa.reshape(lead + (GQA_KV_HEADS, GQA_GROUP, HEAD_DIM)), gqa_q_norm)
    qc = (rms_norm(cq, mla_q_lora_norm) @ w_uq).reshape(lead + (MLA_HEADS, 1, MLA_QK))
    qc = rms_norm(qc, mla_q_norm)
    return qa, qc


def dwconv_centred(z, w):
    n = z.shape[1]
    pad = CONV_WIDTH // 2
    zp = jnp.pad(z, ((0, 0), (pad, pad), (0, 0)))
    return sum(zp[:, j:j + n] * w[j] for j in range(CONV_WIDTH))


def merge_branches(p_rest, y_a, y_c, conv_w, w_out_a, w_out_b, w_out_c, b_gate, w_o):
    xb, gb, gc, g_lin = split_cols(p_rest, COL_SIZES[6:])
    y_b = gb * dwconv_centred(gc * xb, conv_w)
    g_a, g_b, g_c = jnp.split(jax.nn.sigmoid(g_lin + b_gate), N_BRANCH, axis=-1)
    m = g_a * (y_a @ w_out_a) + g_b * (y_b @ w_out_b) + g_c * (y_c @ w_out_c)
    return m @ w_o


def moe(h, w_group, b_group, w_router, b_router, w_gu, w_down):
    shape = h.shape
    t = h.reshape(-1, shape[-1])
    n_tok = t.shape[0]
    n_assign = n_tok * TOP_K
    p_grp = jax.nn.softmax((t @ w_group).astype(jnp.float32) + b_group.astype(jnp.float32), axis=-1)
    g_prob, g_idx = lax.top_k(p_grp, 1)
    logits = ((t @ w_router).astype(jnp.float32) + b_router.astype(jnp.float32))
    logits = logits.reshape(n_tok, N_GROUPS, EXPERTS_PER_GROUP)
    sel = jnp.broadcast_to(g_idx[:, :, None], (n_tok, 1, EXPERTS_PER_GROUP))
    in_grp = jnp.take_along_axis(logits, sel, axis=1)[:, 0]
    e_logit, e_local = lax.top_k(in_grp, TOP_K)
    comb = jax.nn.softmax(e_logit, axis=-1) * g_prob
    expert = (g_idx * EXPERTS_PER_GROUP + e_local).reshape(-1)
    order = jnp.argsort(expert)
    e_sorted = expert[order]
    tok_sorted = (order // TOP_K).astype(jnp.int32)
    w_sorted = comb.reshape(-1)[order].astype(t.dtype)
    sizes = jnp.bincount(expert, length=N_EXPERTS)
    padded = (sizes + MOE_BLOCK - 1) // MOE_BLOCK * MOE_BLOCK
    pad_end = jnp.cumsum(padded)
    pad_start = pad_end - padded
    start = jnp.cumsum(sizes) - sizes
    dest = pad_start[e_sorted] + jnp.arange(n_assign) - start[e_sorted]
    n_slots = (n_assign + MOE_BLOCK - 1) // MOE_BLOCK * MOE_BLOCK + N_EXPERTS * MOE_BLOCK
    n_blocks = n_slots // MOE_BLOCK
    slot_tok = jnp.zeros((n_slots,), jnp.int32).at[dest].set(tok_sorted)
    slot_w = jnp.zeros((n_slots,), t.dtype).at[dest].set(w_sorted)
    block_expert = jnp.minimum(
        jnp.searchsorted(pad_end, jnp.arange(n_blocks) * MOE_BLOCK, side='right'), N_EXPERTS - 1)
    xs = t[slot_tok].reshape(n_blocks, MOE_BLOCK, shape[-1])

    def expert_block(args):
        xblk, e = args
        gu = xblk @ w_gu[e]
        return (jax.nn.silu(gu[:, :D_EXPERT]) * gu[:, D_EXPERT:]) @ w_down[e]

    ys = lax.map(expert_block, (xs, block_expert)).reshape(n_slots, shape[-1]) * slot_w[:, None]
    return jnp.zeros_like(t).at[slot_tok].add(ys).reshape(shape)


def setup_inputs(seed: int = 0) -> dict:
    key = jax.random.key(seed)
    ks = iter(jax.random.split(key, 40))

    def nrm(shape, scale):
        return jax.random.normal(next(ks), shape, jnp.float32) * scale

    def gain(shape):
        return 1.0 + 0.02 * jax.random.normal(next(ks), shape, jnp.float32)

    L, D = DEPTH, D_MODEL
    return {
        'x': nrm((BATCH, SEQ, D), 1.0),
        'c': nrm((BATCH, D), 1.0),
        'ctx': nrm((BATCH, CTX_LEN, D), 1.0),
        'c_ctx': nrm((D,), 1.0),
        'w_mod': nrm((L, D, 6 * D), D ** -0.5),
        'b_mod': nrm((L, 6 * D), 0.01),
        'norm1': gain((L, D)),
        'norm2': gain((L, D)),
        'w_in': nrm((L, D, IN_COLS), D ** -0.5),
        'gqa_q_norm': gain((L, HEAD_DIM)),
        'gqa_k_norm': gain((L, HEAD_DIM)),
        'mla_q_lora_norm': gain((L, MLA_Q_LORA)),
        'w_uq': nrm((L, MLA_Q_LORA, MLA_HEADS * MLA_QK), MLA_Q_LORA ** -0.5),
        'mla_kv_lora_norm': gain((L, MLA_KV_LORA)),
        'w_ukv': nrm((L, MLA_KV_LORA, MLA_HEADS * (MLA_NOPE + MLA_V)), MLA_KV_LORA ** -0.5),
        'mla_q_norm': gain((L, MLA_QK)),
        'mla_k_norm': gain((L, MLA_QK)),
        'conv_w': nrm((L, CONV_WIDTH, CONV_DIM), CONV_WIDTH ** -0.5),
        'w_out_a': nrm((L, GQA_HEADS * HEAD_DIM, D), (GQA_HEADS * HEAD_DIM) ** -0.5),
        'w_out_b': nrm((L, CONV_DIM, D), CONV_DIM ** -0.5),
        'w_out_c': nrm((L, MLA_HEADS * MLA_V, D), (MLA_HEADS * MLA_V) ** -0.5),
        'b_gate': nrm((L, N_BRANCH * D), 0.01),
        'w_o': nrm((L, D, D), D ** -0.5),
        'w_group': nrm((L, D, N_GROUPS), D ** -0.5),
        'b_group': nrm((L, N_GROUPS), 0.01),
        'w_router': nrm((L, D, N_EXPERTS), D ** -0.5),
        'b_router': nrm((L, N_EXPERTS), 0.01),
        'w_gu': nrm((L, N_EXPERTS, D, 2 * D_EXPERT), D ** -0.5),
        'w_down': nrm((L, N_EXPERTS, D_EXPERT, D), D_EXPERT ** -0.5),
    }


def reference(x, c, ctx, c_ctx, w_mod, b_mod, norm1, norm2, w_in, gqa_q_norm, gqa_k_norm,
              mla_q_lora_norm, w_uq, mla_kv_lora_norm, w_ukv, mla_q_norm, mla_k_norm,
              conv_w, w_out_a, w_out_b, w_out_c, b_gate, w_o,
              w_group, b_group, w_router, b_router, w_gu, w_down):
    n_lat = x.shape[1]
    rows_n = n_lat // GRID_W
    rows = jnp.repeat(jnp.arange(rows_n, dtype=jnp.float32), GRID_W)
    cols = jnp.tile(jnp.arange(GRID_W, dtype=jnp.float32), rows_n)
    cos_a, sin_a = rope_tables(rows, cols, HEAD_DIM)
    cos_c, sin_c = rope_tables(rows, cols, MLA_ROPE)
    c_act = jax.nn.silu(c)[:, None, :]
    cc_act = jax.nn.silu(c_ctx)[None, None, :]
    for i in range(DEPTH):
        last = i == DEPTH - 1
        sh1, sc1, g1, sh2, sc2, g2 = jnp.split(c_act @ w_mod[i] + b_mod[i], 6, axis=-1)
        xsh1, xsc1, xg1, xsh2, xsc2, xg2 = jnp.split(cc_act @ w_mod[i] + b_mod[i], 6, axis=-1)
        kv_args = (gqa_k_norm[i], mla_kv_lora_norm[i], w_ukv[i], mla_k_norm[i])
        q_args = (gqa_q_norm[i], mla_q_lora_norm[i], w_uq[i], mla_q_norm[i])
        mix_args = (conv_w[i], w_out_a[i], w_out_b[i], w_out_c[i], b_gate[i], w_o[i])
        moe_args = (w_group[i], b_group[i], w_router[i], b_router[i], w_gu[i], w_down[i])
        h = rms_norm(x, norm1[i]) * (1 + sc1) + sh1
        hc = rms_norm(ctx, norm1[i]) * (1 + xsc1) + xsh1
        p = h @ w_in[i]
        pc = hc @ (w_in[i][:, :KV_COLS] if last else w_in[i])
        ka_x, va_x, kc_x, vc_x = attn_keys(pc[..., :KV_COLS], *kv_args)
        ka, va, kc, vc = attn_keys(p[..., :KV_COLS], *kv_args)
        qa, qc = attn_queries(p[..., KV_COLS:REST_OFF], *q_args)
        ka = apply_rope(ka, cos_a, sin_a)
        qa = apply_rope(qa, cos_a, sin_a)
        kc = rope_tail(kc, cos_c, sin_c)
        qc = rope_tail(qc, cos_c, sin_c)
        y_a = blocked_attention(qa, jnp.concatenate([ka_x, ka], axis=1), jnp.concatenate([va_x, va], axis=1))
        y_c = blocked_attention(qc, jnp.concatenate([kc_x, kc], axis=1), jnp.concatenate([vc_x, vc], axis=1))
        x = x + g1 * merge_branches(p[..., REST_OFF:], y_a, y_c, *mix_args)
        if not last:
            qa_x, qc_x = attn_queries(pc[..., KV_COLS:REST_OFF], *q_args)
            y_ax = blocked_attention(qa_x, ka_x, va_x)
            y_cx = blocked_attention(qc_x, kc_x, vc_x)
            ctx = ctx + xg1 * merge_branches(pc[..., REST_OFF:], y_ax, y_cx, *mix_args)
            hc2 = rms_norm(ctx, norm2[i]) * (1 + xsc2) + xsh2
            ctx = ctx + xg2 * moe(hc2, *moe_args)
        h2 = rms_norm(x, norm2[i]) * (1 + sc2) + sh2
        x = x + g2 * moe(h2, *moe_args)
    return x
```

```cpp
#include <hip/hip_runtime.h>
#include <hip/hip_bf16.h>
#include <cstdio>
#include <cstdint>

#ifndef MK_CHECK
#define MK_CHECK 0
#endif
#ifndef MK_PER_PHASE
#define MK_PER_PHASE 0
#endif

#define LAS __attribute__((address_space(3)))
typedef unsigned short bf16_t;
typedef short bf16x8 __attribute__((ext_vector_type(8)));
typedef short s16x4 __attribute__((ext_vector_type(4)));
typedef float f32x4 __attribute__((ext_vector_type(4)));
typedef float f32x2 __attribute__((ext_vector_type(2)));
typedef float f32x16 __attribute__((ext_vector_type(16)));
typedef unsigned u32x4 __attribute__((ext_vector_type(4)));
typedef unsigned u32x2 __attribute__((ext_vector_type(2)));

constexpr int D = 2048, NB = 4, SEQ = 4096, CL = 256, LKV = SEQ + CL;
constexpr int TX = NB * SEQ, TC = NB * CL, MT = TX + TC;
constexpr int INC = 11584, INCP = 11776;
constexpr int C_K = 0, C_V = 256, C_CKV = 512, C_KR = 768, C_Q = 832, C_CQ = 1856, C_XB = 2368, C_GB = 3392, C_GC = 4416, C_GL = 5440;
constexpr int G8_T0 = 22, G8_OFF = G8_T0 * 256 * 2;
constexpr int NE = 32, DE = 512;
constexpr float EPS = 1e-6f;
constexpr int MAXBLK = 168, MAXSLOT = MAXBLK * 256;

__device__ __forceinline__ float bf2f(bf16_t b) { return __uint_as_float(((unsigned)b) << 16); }
#define BF_LO(w) __uint_as_float((w) << 16)
#define BF_HI(w) __uint_as_float((w) & 0xffff0000u)
__device__ __forceinline__ unsigned cvt_pk_bf16(float lo, float hi) { unsigned r; asm volatile("v_cvt_pk_bf16_f32 %0, %1, %2" : "=v"(r) : "v"(lo), "v"(hi)); return r; }
__device__ __forceinline__ bf16_t f2bf(float x) { return (bf16_t)(cvt_pk_bf16(x, 0.f) & 0xffffu); }
__device__ __forceinline__ float clamp8(float x) { return fminf(fmaxf(x, -448.f), 448.f); }
__device__ __forceinline__ int pk4_fp8(float a, float b, float c, float d) { int w = __builtin_amdgcn_cvt_pk_fp8_f32(clamp8(a), clamp8(b), 0, false); return __builtin_amdgcn_cvt_pk_fp8_f32(clamp8(c), clamp8(d), w, true); }
constexpr float S8_WU = 256.f;
constexpr float S8_QK = 16.f;
constexpr float S8_P = 16.f, S8_V = 16.f, S8_Y = 16.f;
constexpr float S8_H = 16.f, S8_W = 1024.f, S8_ACT = 8.f, S8_WD = 512.f, S8_G = 16.f;
__device__ __forceinline__ float wave_sum(float v) {
    v += __int_as_float(__builtin_amdgcn_ds_swizzle(__float_as_int(v), 0x041F));
    v += __int_as_float(__builtin_amdgcn_ds_swizzle(__float_as_int(v), 0x081F));
    v += __int_as_float(__builtin_amdgcn_ds_swizzle(__float_as_int(v), 0x101F));
    v += __int_as_float(__builtin_amdgcn_ds_swizzle(__float_as_int(v), 0x201F));
    v += __int_as_float(__builtin_amdgcn_ds_swizzle(__float_as_int(v), 0x401F));
    auto rr = __builtin_amdgcn_permlane32_swap(__float_as_uint(v), __float_as_uint(v), false, false);
    return __uint_as_float(rr[0]) + __uint_as_float(rr[1]);
}
__device__ __forceinline__ float rdlane(float v, int l) { return __int_as_float(__builtin_amdgcn_readlane(__float_as_int(v), l)); }
__device__ __forceinline__ int uni(int v) { return __builtin_amdgcn_readfirstlane(v); }
template <class T> __device__ __forceinline__ T* uniptr(T* p) { const unsigned long long v = (unsigned long long)p; const unsigned lo = (unsigned)__builtin_amdgcn_readfirstlane((int)(unsigned)v), hi = (unsigned)__builtin_amdgcn_readfirstlane((int)(unsigned)(v >> 32)); return (T*)(((unsigned long long)hi << 32) | lo); }
template <class T> __device__ __forceinline__ T* lptr(T* p) { long z = 0; asm volatile("" : "+s"(z)); return (T*)((unsigned char*)p + z); }
__device__ __forceinline__ int ltid() { int t = threadIdx.x; asm volatile("" : "+v"(t)); return t; }
__device__ __forceinline__ float sigmoidf_(float x) { return 1.0f / (1.0f + __expf(-x)); }
__device__ __forceinline__ float sigmoidr_(float x) { return __builtin_amdgcn_rcpf(1.0f + __expf(-x)); }

#define XB_TMO      128
#define XB_XCNT(j)  (256  + 64 * (j))
#define XB_XSUB(j)  (1280 + 64 * (j))
#define XB_XGEN(j)  (2304 + 64 * (j))
#define XB_TOP      3328
#define XB_TOPGEN   3392
#define XCD_BAR_WORDS 3456
#define XB_SPIN_CAP (1u << 18)

__device__ __forceinline__ unsigned xb_ld(unsigned* p)              { return __hip_atomic_load(p, __ATOMIC_RELAXED, __HIP_MEMORY_SCOPE_AGENT); }
__device__ __forceinline__ unsigned xb_add(unsigned* p, unsigned v) { return __hip_atomic_fetch_add(p, v, __ATOMIC_RELAXED, __HIP_MEMORY_SCOPE_AGENT); }
__device__ __forceinline__ unsigned xb_xcc_id() { return (unsigned)__builtin_amdgcn_s_getreg((3 << 11) | 20) & 0xFu; }
#define XB_SPIN(cond, bar) do { unsigned _sp = 0; while (cond) { __builtin_amdgcn_s_sleep(1); \
    if ((++_sp & 255u) == 0u) { if (xb_ld(&(bar)[XB_TMO])) break; if (_sp > XB_SPIN_CAP) { atomicAdd(&(bar)[XB_TMO], 1u); break; } } } } while (0)

struct XcdBarrier { unsigned* bar; unsigned x; volatile LAS unsigned* st; };

__device__ __forceinline__ XcdBarrier xcd_barrier_post(unsigned* bar, volatile LAS unsigned* st) {
    XcdBarrier b; b.bar = bar; b.x = xb_xcc_id(); b.st = st;
    if (threadIdx.x == 0) (void)xb_add(&bar[XB_XCNT(b.x)], 1u);
    return b;
}
__device__ __forceinline__ void xcd_barrier_complete(unsigned* bar, unsigned x, unsigned& nloc, unsigned& nx) {
    const unsigned G = gridDim.x * gridDim.y * gridDim.z;
    unsigned sum, cnt, mine, sp = 0u;
    for (;;) {
        sum = 0u; cnt = 0u; mine = 0u;
#pragma unroll
        for (unsigned j = 0; j < 16; ++j) { const unsigned c = xb_ld(&bar[XB_XCNT(j)]); sum += c; cnt += (c > 0u) ? 1u : 0u; mine = (j == x) ? c : mine; }
        if (sum == G) break;
        __builtin_amdgcn_s_sleep(1);
        if ((++sp & 255u) == 0u) { if (xb_ld(&bar[XB_TMO])) break; if (sp > XB_SPIN_CAP) { atomicAdd(&bar[XB_TMO], 1u); break; } }
    }
    nloc = mine > 0u ? mine : 1u; nx = cnt > 0u ? cnt : 1u;
}
__device__ __forceinline__ void xcd_barrier(const XcdBarrier& b) {
    asm volatile("s_waitcnt vmcnt(0)" ::: "memory");
    __syncthreads();
    if (threadIdx.x == 0) {
        unsigned* bar = b.bar;
        __builtin_amdgcn_s_waitcnt(0);
        unsigned nloc = b.st[0], nx = b.st[1];
        if (nloc == 0u) { xcd_barrier_complete(bar, b.x, nloc, nx); b.st[0] = nloc; b.st[1] = nx; }
        const unsigned old = xb_add(&bar[XB_XSUB(b.x)], 1u);
        const unsigned gen = old / nloc;
        if (old + 1u == (gen + 1u) * nloc) {
            __builtin_amdgcn_fence(__ATOMIC_RELEASE, "agent");
            asm volatile("s_waitcnt vmcnt(0)" ::: "memory");
            const unsigned og = xb_add(&bar[XB_TOP], 1u);
            const unsigned tg = og / nx;
            if (og + 1u == (tg + 1u) * nx) xb_add(&bar[XB_TOPGEN], 1u);
            else XB_SPIN(xb_ld(&bar[XB_TOPGEN]) == tg, bar);
            __builtin_amdgcn_fence(__ATOMIC_ACQUIRE, "agent");
            xb_add(&bar[XB_XGEN(b.x)], 1u);
            asm volatile("s_waitcnt vmcnt(0)" ::: "memory");
        } else {
            XB_SPIN(xb_ld(&bar[XB_XGEN(b.x)]) == gen, bar);
            __builtin_amdgcn_fence(__ATOMIC_ACQUIRE, "agent");
            asm volatile("s_waitcnt vmcnt(0)" ::: "memory");
        }
    }
    __syncthreads();
}

namespace pg8 {
constexpr int BM = 256, BK = 64, HALF = 128, HTB = HALF * BK * 2, STAGE_BYTES = 8 * HTB, NXCD = 8, WGM = 8;
__host__ __device__ __forceinline__ int lds_byte(int r, int c) { const int st = (r >> 4) * 2 + (c >> 5), rr = r & 15, cc = c & 31, ob = rr * 64 + cc * 2; return st * 1024 + (ob ^ (((ob >> 9) & 1) << 5)); }
__host__ __device__ __forceinline__ void stage_rc(int b, int& R, int& C) { const int st = b / 1024, sb = b % 1024, swz = sb ^ (((sb >> 9) & 1) << 5); R = (st >> 1) * 16 + swz / 64; C = (st & 1) * 32 + (swz % 64) / 2; }
__host__ __device__ __forceinline__ int perm32(int rho) { const int n = rho >> 4, i = rho & 15; return 8 * (i >> 2) + 4 * n + (i & 3); }

struct Unit { int pm, pn; };
struct Gemm { const bf16_t* A; const bf16_t* Bt; int K, lda, ldb; };

struct GridOrder {
    int nM, nN, nwg, G, c, extra, extraN, cut, skip;
    __device__ void init(int nM_, int nN_, int G_, int c_, int extraM = 0, int extraN_ = 1, int cut_ = 0, int skip_ = 0) { nM = nM_; nN = nN_; nwg = nM * nN; G = G_; c = c_; extraN = extraN_; extra = extraM * extraN_; cut = cut_; skip = skip_; }
    __device__ bool next(int i, Unit& u) const {
        const long L = (long)i * G + c; if (L >= nwg + extra) return false;
        if (L >= nwg) { const int e = (int)L - nwg; u.pm = nM + e / extraN; u.pn = e % extraN; return true; }
        int wgid = (int)L; { const int q = nwg / NXCD, r = nwg % NXCD, xcd = wgid % NXCD, off = wgid / NXCD; wgid = (xcd < r ? xcd * (q + 1) : r * (q + 1) + (xcd - r) * q) + off; }
        const int nig = WGM * nN, gid = wgid / nig, fm = gid * WGM, gsz = (nM - fm) < WGM ? (nM - fm) : WGM;
        u.pm = fm + ((wgid % nig) % gsz); const int pj = (wgid % nig) / gsz; u.pn = (pj < cut) ? pj : pj + skip; return true;
    }
};
struct GridOrderDeal : GridOrder {
    int dl;
    __device__ void deal(int full_, int n1_, int n2_) { dl = full_ | (n1_ << 8) | (n2_ << 20); }
    __device__ bool next(int i, Unit& u) const {
        const int full = dl & 255, n1 = (dl >> 8) & 4095, n2 = dl >> 20;
        if (i < full) return GridOrder::next(i, u);
        if (i == full) { if (c >= n1) return false; return GridOrder::next(i, u); }
        if (i == full + 1) { if (c >= n2) return false; GridOrder t = *this; t.c = c + n1 - G; return t.next(i, u); }
        return false;
    }
};
struct MoeOrder {
    int nblk, nper, G, c; const LAS int* blk_e; const LAS int* fblk; const LAS int* ecnt; const int* elist;
    __device__ bool next(int i, Unit& u) const {
        const long L = (long)i * G + c; if (L >= (long)nblk * nper) return false;
        const int blk = (int)L / nper, pl = (int)L % nper; u.pm = blk; u.pn = blk_e[blk] * nper + pl; return true;
    }
    __device__ __forceinline__ int src_row(const Unit& u, int rit) const {
        const int e = u.pn / nper, idx = (u.pm - fblk[e]) * 256 + rit;
        return (idx < ecnt[e]) ? elist[(size_t)e * MT + idx] : 0;
    }
};
struct NoGather { };

typedef f32x4 Acc[2][2][4][2];

template <class Epi, class Sched, bool ALIGN_EPI = true, bool GATHER = false>
__device__ __forceinline__ void gemm_phase(LAS unsigned char* lds, const Gemm g, const Sched& S, const Epi& E) {
    const int tid = ltid(), wid = __builtin_amdgcn_readfirstlane(tid >> 6), lane = tid & 63, wr = wid >> 2, wc = wid & 3, fr = lane & 15, fq = lane >> 4;
    const int K = g.K, nt = K / BK;
    unsigned voffA[2], voffB[2];
#pragma unroll
    for (int i = 0; i < 2; ++i) { int R, C; stage_rc(tid * 16 + i * 8192, R, C); const int Rb = Epi::PERM ? ((R & ~31) + perm32(R & 31)) : R;
        voffA[i] = (unsigned)(R * g.lda + C) * 2u; voffB[i] = (unsigned)(Rb * g.ldb + C) * 2u; }
    unsigned vA0[2], vA1[2];
#define PG8_GROWS(u_, d0, d1) do { _Pragma("unroll") for (int i_ = 0; i_ < 2; ++i_) { int R_, C_; stage_rc(tid * 16 + i_ * 8192, R_, C_); d0[i_] = (unsigned)(S.src_row(u_, R_) * g.lda + C_) * 2u; d1[i_] = (unsigned)(S.src_row(u_, HALF + R_) * g.lda + C_) * 2u; } } while (0)
    const size_t kstep = (size_t)(BK * 2);
    const size_t hstepA = (size_t)HALF * g.lda * 2, hstepB = (size_t)HALF * g.ldb * 2;
    const size_t tstepA = 2 * hstepA, tstepB = 2 * hstepB;
    const unsigned ldsw = (unsigned)wid * 1024u;
    const int aoff = lds_byte(wr * 64 + fr, fq * 8), boff = lds_byte(wc * 32 + fr, fq * 8);
#define PG8_SA(b, h) (((b) * 2 + (h)) * HTB)
#define PG8_SB(b, h) ((4 + (b) * 2 + (h)) * HTB)
#define PG8_STAGE(bufoff, gbase, voff) do { _Pragma("unroll") for (int _i = 0; _i < 2; ++_i) \
        __builtin_amdgcn_global_load_lds((const unsigned*)((const char*)(gbase) + (voff)[_i]), (LAS unsigned*)(lds + (bufoff) + ldsw + _i * 8192), 16, 0, 0); } while (0)
#define PG8_LDA(dst, b, h) do { _Pragma("unroll") for (int m = 0; m < 4; ++m) _Pragma("unroll") for (int k = 0; k < 2; ++k) dst[m][k] = *(const LAS bf16x8*)(lds + PG8_SA(b, h) + aoff + m * 2048 + k * 1024); } while (0)
#define PG8_LDB(dst, b, h) do { _Pragma("unroll") for (int n = 0; n < 2; ++n) _Pragma("unroll") for (int k = 0; k < 2; ++k) dst[n][k] = *(const LAS bf16x8*)(lds + PG8_SB(b, h) + boff + n * 2048 + k * 1024); } while (0)
#define PG8_MMA(ai, bj, At, Bt) do { __builtin_amdgcn_s_setprio(1); _Pragma("unroll") for (int m = 0; m < 4; ++m) _Pragma("unroll") for (int n = 0; n < 2; ++n) _Pragma("unroll") for (int k = 0; k < 2; ++k) \
        acc[ai][bj][m][n] = __builtin_amdgcn_mfma_f32_16x16x32_bf16(Bt[n][k], At[m][k], acc[ai][bj][m][n], 0, 0, 0); __builtin_amdgcn_s_setprio(0); } while (0)
#define PG8_WAIT_V(n) asm volatile("s_waitcnt vmcnt(" #n ")" ::: "memory")
#define PG8_WAIT_L(n) asm volatile("s_waitcnt lgkmcnt(" #n ")" ::: "memory")
#define PG8_BAR __builtin_amdgcn_s_barrier()
#define PG8_SCHED __builtin_amdgcn_sched_barrier(0)
    Unit cur, nxt; int ui = 0;
    if (!S.next(0, cur)) return;
    Acc acc;
#pragma unroll
    for (int a = 0; a < 2; ++a)
#pragma unroll
        for (int b = 0; b < 2; ++b)
#pragma unroll
            for (int m = 0; m < 4; ++m)
#pragma unroll
                for (int n = 0; n < 2; ++n) acc[a][b][m][n] = (f32x4){0.f, 0.f, 0.f, 0.f};
    bf16x8 At[4][2], B0[2][2], B1[2][2];
    const char* cA = GATHER ? (const char*)g.A : (const char*)g.A + (size_t)cur.pm * tstepA; const char* cB = (const char*)g.Bt + (size_t)cur.pn * tstepB;
    if constexpr (GATHER) { PG8_GROWS(cur, vA0, vA1); }
    PG8_STAGE(PG8_SB(0, 0), cB, voffB); PG8_STAGE(PG8_SB(0, 1), cB + hstepB, voffB);
    if constexpr (GATHER) { PG8_STAGE(PG8_SA(0, 0), cA, vA0); PG8_STAGE(PG8_SA(0, 1), cA, vA1); } else { PG8_STAGE(PG8_SA(0, 0), cA, voffA); PG8_STAGE(PG8_SA(0, 1), cA + hstepA, voffA); }
    if (wr == 1) PG8_BAR;
    PG8_WAIT_V(2); PG8_BAR;
    PG8_STAGE(PG8_SB(1, 0), cB + kstep, voffB); if constexpr (GATHER) PG8_STAGE(PG8_SA(1, 0), cA + kstep, vA0); else PG8_STAGE(PG8_SA(1, 0), cA + kstep, voffA); PG8_STAGE(PG8_SB(1, 1), cB + hstepB + kstep, voffB);
    PG8_WAIT_V(6); PG8_BAR;
    for (;;) {
        const bool has_next = S.next(ui + 1, nxt);
        const char* nA = GATHER ? cA : (has_next ? (const char*)g.A + (size_t)nxt.pm * tstepA : cA); const char* nB = has_next ? (const char*)g.Bt + (size_t)nxt.pn * tstepB : cB;
        for (int t = 0; t < nt; t += 2) {
            const bool last = (t == nt - 2);
            const char* a1 = cA + (size_t)(t + 1) * kstep;
            const char* a2 = last ? nA : cA + (size_t)(t + 2) * kstep; const char* b2 = last ? nB : cB + (size_t)(t + 2) * kstep;
            const char* a3 = a2 + kstep; const char* b3 = b2 + kstep;
            PG8_LDB(B0, 0, 0); PG8_LDB(B1, 0, 1); PG8_SCHED; PG8_LDA(At, 0, 0); if constexpr (GATHER) PG8_STAGE(PG8_SA(1, 1), a1, vA1); else PG8_STAGE(PG8_SA(1, 1), a1 + hstepA, voffA);
            if constexpr (GATHER) { if (last && has_next) PG8_GROWS(nxt, vA0, vA1); }
            PG8_WAIT_V(8); PG8_WAIT_L(0); PG8_BAR; PG8_MMA(0, 0, At, B0); PG8_MMA(0, 1, At, B1); PG8_BAR; PG8_SCHED;
            PG8_LDA(At, 0, 1); PG8_STAGE(PG8_SB(0, 0), b2, voffB); PG8_STAGE(PG8_SB(0, 1), b2 + hstepB, voffB); if constexpr (GATHER) PG8_STAGE(PG8_SA(0, 0), a2, vA0); else PG8_STAGE(PG8_SA(0, 0), a2, voffA);
            PG8_WAIT_V(8); PG8_WAIT_L(0); PG8_BAR; PG8_MMA(1, 0, At, B0); PG8_MMA(1, 1, At, B1); PG8_BAR; PG8_SCHED;
            PG8_LDB(B0, 1, 0); PG8_LDB(B1, 1, 1); PG8_SCHED; PG8_LDA(At, 1, 0); if constexpr (GATHER) PG8_STAGE(PG8_SA(0, 1), a2, vA1); else PG8_STAGE(PG8_SA(0, 1), a2 + hstepA, voffA);
            PG8_WAIT_V(8); PG8_WAIT_L(0); PG8_BAR; PG8_MMA(0, 0, At, B0); PG8_MMA(0, 1, At, B1); PG8_BAR; PG8_SCHED;
            PG8_LDA(At, 1, 1); PG8_STAGE(PG8_SB(1, 0), b3, voffB); PG8_STAGE(PG8_SB(1, 1), b3 + hstepB, voffB); if constexpr (GATHER) PG8_STAGE(PG8_SA(1, 0), a3, vA0); else PG8_STAGE(PG8_SA(1, 0), a3, voffA);
            PG8_WAIT_V(8); PG8_WAIT_L(0); PG8_BAR; PG8_MMA(1, 0, At, B0); PG8_MMA(1, 1, At, B1); PG8_BAR; PG8_SCHED;
        }
        if constexpr (ALIGN_EPI) { if (wr == 0) PG8_BAR; }
        E(acc, cur, wr, wc, fr, fq);
        if (!has_next) break;
#pragma unroll
        for (int a = 0; a < 2; ++a)
#pragma unroll
            for (int b = 0; b < 2; ++b)
#pragma unroll
                for (int m = 0; m < 4; ++m)
#pragma unroll
                    for (int n = 0; n < 2; ++n) acc[a][b][m][n] = (f32x4){0.f, 0.f, 0.f, 0.f};
        cur = nxt; cA = nA; cB = nB; ++ui;
        if constexpr (ALIGN_EPI) { if (wr == 1) PG8_BAR; }
    }
    PG8_WAIT_V(0);
    if constexpr (!ALIGN_EPI) { if (wr == 0) PG8_BAR; }
    PG8_BAR;
#undef PG8_GROWS
#undef PG8_SA
#undef PG8_SB
#undef PG8_STAGE
#undef PG8_LDA
#undef PG8_LDB
#undef PG8_MMA
#undef PG8_WAIT_V
#undef PG8_WAIT_L
#undef PG8_BAR
#undef PG8_SCHED
}

typedef int v8i __attribute__((ext_vector_type(8)));
typedef int v4i __attribute__((ext_vector_type(4)));
template <class Epi, class Sched, bool ALIGN_EPI = true, bool GATHER = false>
__device__ __forceinline__ void gemm_phase8(LAS unsigned char* lds, const Gemm g, const Sched& S, const Epi& E) {
    const int tid = ltid(), wid = __builtin_amdgcn_readfirstlane(tid >> 6), lane = tid & 63, wr = wid >> 2, wc = wid & 3, fr = lane & 15, fq = lane >> 4;
    const int K = g.K, nt = K / 128;
    unsigned voffA[2], voffB[2];
#pragma unroll
    for (int i = 0; i < 2; ++i) { const int q = tid + 512 * i, R = q >> 3, kp = (q & 7) ^ ((R >> 1) & 7); const int Rb = Epi::PERM ? ((R & ~31) + perm32(R & 31)) : R;
        voffA[i] = (unsigned)(R * g.lda + kp * 16); voffB[i] = (unsigned)(Rb * g.ldb + kp * 16); }
    unsigned vA0[2], vA1[2];
#define PG8_GROWS(u_, d0, d1) do { _Pragma("unroll") for (int i_ = 0; i_ < 2; ++i_) { const int q_ = tid + 512 * i_, R_ = q_ >> 3, kp_ = (q_ & 7) ^ ((R_ >> 1) & 7); d0[i_] = (unsigned)(S.src_row(u_, R_) * g.lda + kp_ * 16); d1[i_] = (unsigned)(S.src_row(u_, HALF + R_) * g.lda + kp_ * 16); } } while (0)
    const size_t kstep = 128;
    const size_t hstepA = (size_t)HALF * g.lda, hstepB = (size_t)HALF * g.ldb;
    const size_t tstepA = 2 * hstepA, tstepB = 2 * hstepB;
    const unsigned ldsw = (unsigned)wid * 1024u;
    const int sw = (fr >> 1) & 7;
    const int aoff0 = (wr * 64 + fr) * 128 + (((2 * fq) ^ sw) << 4), boff0 = (wc * 32 + fr) * 128 + (((2 * fq) ^ sw) << 4);
#define PG8_SA(b, h) (((b) * 2 + (h)) * HTB)
#define PG8_SB(b, h) ((4 + (b) * 2 + (h)) * HTB)
#define PG8_STAGE(bufoff, gbase, voff) do { _Pragma("unroll") for (int _i = 0; _i < 2; ++_i) \
        __builtin_amdgcn_global_load_lds((const unsigned*)((const char*)(gbase) + (voff)[_i]), (LAS unsigned*)(lds + (bufoff) + ldsw + _i * 8192), 16, 0, 0); } while (0)
#define PG8_FR(dst, off0, off1) do { const v4i lo_ = *(const LAS v4i*)(lds + (off0)), hi_ = *(const LAS v4i*)(lds + (off1)); \
        dst = __builtin_shufflevector(lo_, hi_, 0, 1, 2, 3, 4, 5, 6, 7); } while (0)
#define PG8_LDA(dst, b, h) do { _Pragma("unroll") for (int m = 0; m < 4; ++m) PG8_FR(dst[m], PG8_SA(b, h) + aoff0 + m * 2048, PG8_SA(b, h) + (aoff0 ^ 16) + m * 2048); } while (0)
#define PG8_LDB(dst, b, h) do { _Pragma("unroll") for (int n = 0; n < 2; ++n) PG8_FR(dst[n], PG8_SB(b, h) + boff0 + n * 2048, PG8_SB(b, h) + (boff0 ^ 16) + n * 2048); } while (0)
#define PG8_MMA(ai, bj, At, Bt) do { __builtin_amdgcn_s_setprio(1); _Pragma("unroll") for (int m = 0; m < 4; ++m) _Pragma("unroll") for (int n = 0; n < 2; ++n) \
        asm volatile("v_mfma_f32_16x16x128_f8f6f4 %0, %1, %2, %0" : "+v"(acc[ai][bj][m][n]) : "v"(Bt[n]), "v"(At[m])); __builtin_amdgcn_s_setprio(0); } while (0)
#define PG8_WAIT_V(n) asm volatile("s_waitcnt vmcnt(" #n ")" ::: "memory")
#define PG8_WAIT_L(n) asm volatile("s_waitcnt lgkmcnt(" #n ")" ::: "memory")
#define PG8_BAR __builtin_amdgcn_s_barrier()
#define PG8_SCHED __builtin_amdgcn_sched_barrier(0)
    Unit cur, nxt; int ui = 0;
    if (!S.next(0, cur)) return;
    cur.pm = uni(cur.pm); cur.pn = uni(cur.pn);
    const char* const gA = (const char*)uniptr(g.A); const char* const gB = (const char*)uniptr(g.Bt);
    Acc acc;
#pragma unroll
    for (int a = 0; a < 2; ++a)
#pragma unroll
        for (int b = 0; b < 2; ++b)
#pragma unroll
            for (int m = 0; m < 4; ++m)
#pragma unroll
                for (int n = 0; n < 2; ++n) acc[a][b][m][n] = (f32x4){0.f, 0.f, 0.f, 0.f};
    v8i At[4], B0[2], B1[2];
    const char* cA = GATHER ? gA : gA + (size_t)cur.pm * tstepA; const char* cB = gB + (size_t)cur.pn * tstepB;
    if constexpr (GATHER) { PG8_GROWS(cur, vA0, vA1); }
    PG8_STAGE(PG8_SB(0, 0), cB, voffB); PG8_STAGE(PG8_SB(0, 1), cB + hstepB, voffB);
    if constexpr (GATHER) { PG8_STAGE(PG8_SA(0, 0), cA, vA0); PG8_STAGE(PG8_SA(0, 1), cA, vA1); } else { PG8_STAGE(PG8_SA(0, 0), cA, voffA); PG8_STAGE(PG8_SA(0, 1), cA + hstepA, voffA); }
    if (wr == 1) PG8_BAR;
    PG8_WAIT_V(2); PG8_BAR;
    PG8_STAGE(PG8_SB(1, 0), cB + kstep, voffB); if constexpr (GATHER) PG8_STAGE(PG8_SA(1, 0), cA + kstep, vA0); else PG8_STAGE(PG8_SA(1, 0), cA + kstep, voffA); PG8_STAGE(PG8_SB(1, 1), cB + hstepB + kstep, voffB);
    PG8_WAIT_V(6); PG8_BAR;
    for (;;) {
        const bool has_next = uni((int)S.next(ui + 1, nxt)) != 0; nxt.pm = uni(nxt.pm); nxt.pn = uni(nxt.pn);
        const char* nA = GATHER ? cA : (has_next ? gA + (size_t)nxt.pm * tstepA : cA); const char* nB = has_next ? gB + (size_t)nxt.pn * tstepB : cB;
        for (int t = 0; t < nt; t += 2) {
            const bool last = (t == nt - 2);
            const char* a1 = cA + (size_t)(t + 1) * kstep;
            const char* a2 = last ? nA : cA + (size_t)(t + 2) * kstep; const char* b2 = last ? nB : cB + (size_t)(t + 2) * kstep;
            const char* a3 = a2 + kstep; const char* b3 = b2 + kstep;
            PG8_LDB(B0, 0, 0); PG8_LDB(B1, 0, 1); PG8_SCHED; PG8_LDA(At, 0, 0); if constexpr (GATHER) PG8_STAGE(PG8_SA(1, 1), a1, vA1); else PG8_STAGE(PG8_SA(1, 1), a1 + hstepA, voffA);
            if constexpr (GATHER) { if (last && has_next) PG8_GROWS(nxt, vA0, vA1); }
            PG8_WAIT_V(8); PG8_WAIT_L(0); PG8_BAR; PG8_MMA(0, 0, At, B0); PG8_MMA(0, 1, At, B1); PG8_BAR; PG8_SCHED;
            PG8_LDA(At, 0, 1); PG8_STAGE(PG8_SB(0, 0), b2, voffB); PG8_STAGE(PG8_SB(0, 1), b2 + hstepB, voffB); if constexpr (GATHER) PG8_STAGE(PG8_SA(0, 0), a2, vA0); else PG8_STAGE(PG8_SA(0, 0), a2, voffA);
            PG8_WAIT_V(8); PG8_WAIT_L(0); PG8_BAR; PG8_MMA(1, 0, At, B0); PG8_MMA(1, 1, At, B1); PG8_BAR; PG8_SCHED;
            PG8_LDB(B0, 1, 0); PG8_LDB(B1, 1, 1); PG8_SCHED; PG8_LDA(At, 1, 0); if constexpr (GATHER) PG8_STAGE(PG8_SA(0, 1), a2, vA1); else PG8_STAGE(PG8_SA(0, 1), a2 + hstepA, voffA);
            PG8_WAIT_V(8); PG8_WAIT_L(0); PG8_BAR; PG8_MMA(0, 0, At, B0); PG8_MMA(0, 1, At, B1); PG8_BAR; PG8_SCHED;
            PG8_LDA(At, 1, 1); PG8_STAGE(PG8_SB(1, 0), b3, voffB); PG8_STAGE(PG8_SB(1, 1), b3 + hstepB, voffB); if constexpr (GATHER) PG8_STAGE(PG8_SA(1, 0), a3, vA0); else PG8_STAGE(PG8_SA(1, 0), a3, voffA);
            PG8_WAIT_V(8); PG8_WAIT_L(0); PG8_BAR; PG8_MMA(1, 0, At, B0); PG8_MMA(1, 1, At, B1); PG8_BAR; PG8_SCHED;
        }
        asm volatile("s_nop 15\n\ts_nop 7" ::: "memory");
        if constexpr (ALIGN_EPI) { if (wr == 0) PG8_BAR; }
        E(acc, cur, wr, wc, fr, fq);
        if (!has_next) break;
#pragma unroll
        for (int a = 0; a < 2; ++a)
#pragma unroll
            for (int b = 0; b < 2; ++b)
#pragma unroll
                for (int m = 0; m < 4; ++m)
#pragma unroll
                    for (int n = 0; n < 2; ++n) acc[a][b][m][n] = (f32x4){0.f, 0.f, 0.f, 0.f};
        cur = nxt; cA = nA; cB = nB; ++ui;
        if constexpr (ALIGN_EPI) { if (wr == 1) PG8_BAR; }
    }
    PG8_WAIT_V(0);
    if constexpr (!ALIGN_EPI) { if (wr == 0) PG8_BAR; }
    PG8_BAR;
#undef PG8_GROWS
#undef PG8_SA
#undef PG8_SB
#undef PG8_STAGE
#undef PG8_FR
#undef PG8_LDA
#undef PG8_LDB
#undef PG8_MMA
#undef PG8_WAIT_V
#undef PG8_WAIT_L
#undef PG8_BAR
#undef PG8_SCHED
}

struct EpiBf16 {
    static constexpr bool PERM = true;
    bf16_t* O; int ldc; float scale;
    __device__ __forceinline__ void operator()(const Acc& acc, const Unit& u, int wr, int wc, int fr, int fq) const {
        const int row0 = u.pm * BM + wr * 64 + fr, col0 = u.pn * BM + wc * 32 + 8 * fq;
#pragma unroll
        for (int ai = 0; ai < 2; ++ai)
#pragma unroll
            for (int m = 0; m < 4; ++m) { bf16_t* rowp = O + (size_t)(row0 + ai * HALF + m * 16) * ldc + col0;
#pragma unroll
                for (int bj = 0; bj < 2; ++bj) { const f32x4 v0 = acc[ai][bj][m][0] * scale, v1 = acc[ai][bj][m][1] * scale;
                    u32x4 w; w.x = cvt_pk_bf16(v0[0], v0[1]); w.y = cvt_pk_bf16(v0[2], v0[3]); w.z = cvt_pk_bf16(v1[0], v1[1]); w.w = cvt_pk_bf16(v1[2], v1[3]);
                    *(u32x4*)(rowp + bj * HALF) = w; } }
    }
};
struct EpiP8 {
    static constexpr bool PERM = true;
    bf16_t* O; int ldc; float scale;
    __device__ __forceinline__ void operator()(const Acc& acc, const Unit& u, int wr, int wc, int fr, int fq) const {
        const int row0 = u.pm * BM + wr * 64 + fr;
        if (u.pn < G8_T0) { const int col0 = u.pn * BM + wc * 32 + 8 * fq;
#pragma unroll
            for (int ai = 0; ai < 2; ++ai)
#pragma unroll
                for (int m = 0; m < 4; ++m) { bf16_t* rowp = O + (size_t)(row0 + ai * HALF + m * 16) * ldc + col0;
#pragma unroll
                    for (int bj = 0; bj < 2; ++bj) { const f32x4 v0 = acc[ai][bj][m][0] * scale, v1 = acc[ai][bj][m][1] * scale;
                        u32x4 w; w.x = cvt_pk_bf16(v0[0], v0[1]); w.y = cvt_pk_bf16(v0[2], v0[3]); w.z = cvt_pk_bf16(v1[0], v1[1]); w.w = cvt_pk_bf16(v1[2], v1[3]);
                        *(u32x4*)(rowp + bj * HALF) = w; } }
        } else { const int g0 = u.pn * BM - C_GL + wc * 32 + 8 * fq; const float sg = scale * S8_G;
#pragma unroll
            for (int ai = 0; ai < 2; ++ai)
#pragma unroll
                for (int m = 0; m < 4; ++m) { unsigned char* rowp = (unsigned char*)(O + (size_t)(row0 + ai * HALF + m * 16) * ldc) + G8_OFF + g0;
#pragma unroll
                    for (int bj = 0; bj < 2; ++bj) { const f32x4 v0 = acc[ai][bj][m][0] * sg, v1 = acc[ai][bj][m][1] * sg;
                        u32x2 w; w.x = (unsigned)pk4_fp8(v0[0], v0[1], v0[2], v0[3]); w.y = (unsigned)pk4_fp8(v1[0], v1[1], v1[2], v1[3]);
                        *(u32x2*)(rowp + bj * HALF) = w; } }
        }
    }
};
struct EpiBf16G {
    static constexpr bool PERM = true;
    bf16_t* O; int ldc; float scale;
    __device__ __forceinline__ void operator()(const Acc& acc, const Unit& u, int wr, int wc, int fr, int fq) const {
        const int row0 = u.pm * BM + wr * 64 + fr, col0 = u.pn * BM + wc * 32 + 8 * fq;
        const bool gt = (u.pn == G8_T0 - 1);
#pragma unroll
        for (int ai = 0; ai < 2; ++ai)
#pragma unroll
            for (int m = 0; m < 4; ++m) { bf16_t* rowp = O + (size_t)(row0 + ai * HALF + m * 16) * ldc + col0;
#pragma unroll
                for (int bj = 0; bj < 2; ++bj) { const f32x4 v0 = acc[ai][bj][m][0] * scale, v1 = acc[ai][bj][m][1] * scale;
                    u32x4 w; w.x = cvt_pk_bf16(v0[0], v0[1]); w.y = cvt_pk_bf16(v0[2], v0[3]); w.z = cvt_pk_bf16(v1[0], v1[1]); w.w = cvt_pk_bf16(v1[2], v1[3]);
                    *(u32x4*)(rowp + bj * HALF) = w;
                    const int g = col0 + bj * HALF - C_GL;
                    if (gt && g >= 0) { u32x2 w8; w8.x = (unsigned)pk4_fp8(v0[0] * S8_G, v0[1] * S8_G, v0[2] * S8_G, v0[3] * S8_G); w8.y = (unsigned)pk4_fp8(v1[0] * S8_G, v1[1] * S8_G, v1[2] * S8_G, v1[3] * S8_G);
                        *(u32x2*)((unsigned char*)(O + (size_t)(row0 + ai * HALF + m * 16) * ldc) + G8_OFF + g) = w8; } } }
    }
};
struct EpiBf16Moe {
    static constexpr bool PERM = true;
    bf16_t* O; int ldc; int nper; float scale;
    __device__ __forceinline__ void operator()(const Acc& acc, const Unit& u, int wr, int wc, int fr, int fq) const {
        const int row0 = u.pm * BM + wr * 64 + fr, col0 = (u.pn % nper) * BM + wc * 32 + 8 * fq;
#pragma unroll
        for (int ai = 0; ai < 2; ++ai)
#pragma unroll
            for (int m = 0; m < 4; ++m) { bf16_t* rowp = O + (size_t)(row0 + ai * HALF + m * 16) * ldc + col0;
#pragma unroll
                for (int bj = 0; bj < 2; ++bj) { const f32x4 v0 = acc[ai][bj][m][0] * scale, v1 = acc[ai][bj][m][1] * scale;
                    u32x4 w; w.x = cvt_pk_bf16(v0[0], v0[1]); w.y = cvt_pk_bf16(v0[2], v0[3]); w.z = cvt_pk_bf16(v1[0], v1[1]); w.w = cvt_pk_bf16(v1[2], v1[3]);
                    *(u32x4*)(rowp + bj * HALF) = w; } }
    }
};
#define G8_DECODE(gl8, w2) do { const auto p0_ = __builtin_amdgcn_cvt_pk_f32_fp8((int)(w2).x, false), p1_ = __builtin_amdgcn_cvt_pk_f32_fp8((int)(w2).x, true), \
        p2_ = __builtin_amdgcn_cvt_pk_f32_fp8((int)(w2).y, false), p3_ = __builtin_amdgcn_cvt_pk_f32_fp8((int)(w2).y, true); \
        gl8[0] = p0_[0]; gl8[1] = p0_[1]; gl8[2] = p1_[0]; gl8[3] = p1_[1]; gl8[4] = p2_[0]; gl8[5] = p2_[1]; gl8[6] = p3_[0]; gl8[7] = p3_[1]; } while (0)
template <bool ACCUM>
struct EpiGateT {
    static constexpr bool PERM = true;
    bf16_t* Mo; const unsigned char* gate; int ldg; const float* bgate; float ascale;
    __device__ __forceinline__ void operator()(const Acc& acc, const Unit& u, int wr, int wc, int fr, int fq) const {
        const int row0 = u.pm * BM + wr * 64 + fr, col0 = u.pn * BM + wc * 32 + 8 * fq;
        f32x4 bv[2][2];
#pragma unroll
        for (int bj = 0; bj < 2; ++bj)
#pragma unroll
            for (int n = 0; n < 2; ++n) bv[bj][n] = *(const f32x4*)(bgate + col0 + bj * HALF + 4 * n);
#pragma unroll
        for (int ai = 0; ai < 2; ++ai) {
            u32x2 gw[4][2]; u32x4 pw[4][2];
#pragma unroll
            for (int m = 0; m < 4; ++m) { const size_t r = (size_t)(row0 + ai * HALF + m * 16);
#pragma unroll
                for (int bj = 0; bj < 2; ++bj) { gw[m][bj] = *(const u32x2*)(gate + r * ldg + col0 + bj * HALF);
                    pw[m][bj] = (u32x4){0u, 0u, 0u, 0u}; if (ACCUM) pw[m][bj] = *(const u32x4*)(Mo + r * D + col0 + bj * HALF); } }
            asm volatile("" ::: "memory");
#pragma unroll
            for (int m = 0; m < 4; ++m) { const size_t r = (size_t)(row0 + ai * HALF + m * 16);
#pragma unroll
                for (int bj = 0; bj < 2; ++bj) { float o[8], gl8[8]; G8_DECODE(gl8, gw[m][bj]);
#pragma unroll
                    for (int j = 0; j < 8; ++j) { const unsigned pword = pw[m][bj][j >> 1];
                        const float gl = gl8[j] * (1.0f / S8_G);
                        const float pv = __uint_as_float((j & 1) ? (pword & 0xffff0000u) : (pword << 16));
                        const float a = acc[ai][bj][m][j >> 2][j & 3] * ascale;
                        o[j] = pv + sigmoidf_(gl + bv[bj][j >> 2][j & 3]) * a; }
                    u32x4 w; w.x = cvt_pk_bf16(o[0], o[1]); w.y = cvt_pk_bf16(o[2], o[3]); w.z = cvt_pk_bf16(o[4], o[5]); w.w = cvt_pk_bf16(o[6], o[7]);
                    *(u32x4*)(Mo + r * D + col0 + bj * HALF) = w; } }
        }
    }
};
struct EpiGateLite {
    static constexpr bool PERM = true;
    bf16_t* Mo; const unsigned char* gate; int ldg; const float* bgate; bool ACCUM; float ascale;
    __device__ __forceinline__ void operator()(const Acc& acc, const Unit& u, int wr, int wc, int fr, int fq) const {
        const int row0 = u.pm * BM + wr * 64 + fr, col0 = u.pn * BM + wc * 32 + 8 * fq;
#pragma unroll
        for (int ai = 0; ai < 2; ++ai)
#pragma unroll
            for (int m = 0; m < 4; ++m) { const size_t r = (size_t)(row0 + ai * HALF + m * 16);
#pragma unroll
                for (int bj = 0; bj < 2; ++bj) {
                    const u32x2 gw = *(const u32x2*)(gate + r * ldg + col0 + bj * HALF);
                    u32x4 pw = (u32x4){0u, 0u, 0u, 0u}; if (ACCUM) pw = *(const u32x4*)(Mo + r * D + col0 + bj * HALF);
                    const f32x4 b0 = *(const f32x4*)(bgate + col0 + bj * HALF), b1 = *(const f32x4*)(bgate + col0 + bj * HALF + 4);
                    float o[8], gl8[8]; G8_DECODE(gl8, gw);
#pragma unroll
                    for (int j = 0; j < 8; ++j) { const unsigned pword = pw[j >> 1];
                        const float gl = gl8[j] * (1.0f / S8_G);
                        const float pv = __uint_as_float((j & 1) ? (pword & 0xffff0000u) : (pword << 16));
                        const float a = acc[ai][bj][m][j >> 2][j & 3] * ascale;
                        o[j] = pv + sigmoidf_(gl + ((j < 4) ? b0[j & 3] : b1[j & 3])) * a; }
                    u32x4 w; w.x = cvt_pk_bf16(o[0], o[1]); w.y = cvt_pk_bf16(o[2], o[3]); w.z = cvt_pk_bf16(o[4], o[5]); w.w = cvt_pk_bf16(o[6], o[7]);
                    *(u32x4*)(Mo + r * D + col0 + bj * HALF) = w; } }
    }
};
struct EpiResid {
    static constexpr bool PERM = true;
    const float* xi_lo; const float* xi_hi; const bf16_t* xi_bf; bf16_t* Xo; const float* gmod; int gstride;
    __device__ __forceinline__ void operator()(const Acc& acc, const Unit& u, int wr, int wc, int fr, int fq) const {
        const int row0 = u.pm * BM + wr * 64 + fr, col0 = u.pn * BM + wc * 32 + 8 * fq;
        const int rb = (u.pm * BM < TX) ? (u.pm * BM) / SEQ : NB;
        const float* xi = (u.pm * BM < TX) ? xi_lo : xi_hi;
        f32x4 gv[2][2];
#pragma unroll
        for (int bj = 0; bj < 2; ++bj)
#pragma unroll
            for (int n = 0; n < 2; ++n) gv[bj][n] = *(const f32x4*)(gmod + (size_t)rb * gstride + col0 + bj * HALF + 4 * n);
#pragma unroll
        for (int ai = 0; ai < 2; ++ai)
#pragma unroll
            for (int m = 0; m < 4; ++m) { const size_t off = (size_t)(row0 + ai * HALF + m * 16) * D + col0;
#pragma unroll
                for (int bj = 0; bj < 2; ++bj) { f32x4 b0, b1;
                    if (xi_bf) { const u32x4 w = *(const u32x4*)(xi_bf + off + bj * HALF); b0 = (f32x4){BF_LO(w.x), BF_HI(w.x), BF_LO(w.y), BF_HI(w.y)}; b1 = (f32x4){BF_LO(w.z), BF_HI(w.z), BF_LO(w.w), BF_HI(w.w)}; }
                    else { b0 = *(const f32x4*)(xi + off + bj * HALF); b1 = *(const f32x4*)(xi + off + bj * HALF + 4); }
                    const f32x4 v0 = b0 + gv[bj][0] * acc[ai][bj][m][0], v1 = b1 + gv[bj][1] * acc[ai][bj][m][1];
                    u32x4 w; w.x = cvt_pk_bf16(v0[0], v0[1]); w.y = cvt_pk_bf16(v0[2], v0[3]); w.z = cvt_pk_bf16(v1[0], v1[1]); w.w = cvt_pk_bf16(v1[2], v1[3]);
                    *(u32x4*)(Xo + off + bj * HALF) = w; }
                if (m == 3) asm volatile("" ::: "memory"); }
    }
};
struct EpiDelta {
    static constexpr bool PERM = true;
    bf16_t* DX; const float* gmod; int gstride;
    __device__ __forceinline__ void operator()(const Acc& acc, const Unit& u, int wr, int wc, int fr, int fq) const {
        const int row0 = u.pm * BM + wr * 64 + fr, col0 = u.pn * BM + wc * 32 + 8 * fq;
        const int rb = (u.pm * BM < TX) ? (u.pm * BM) / SEQ : NB;
        f32x4 gv[2][2];
#pragma unroll
        for (int bj = 0; bj < 2; ++bj)
#pragma unroll
            for (int n = 0; n < 2; ++n) gv[bj][n] = *(const f32x4*)(gmod + (size_t)rb * gstride + col0 + bj * HALF + 4 * n);
#pragma unroll
        for (int ai = 0; ai < 2; ++ai)
#pragma unroll
            for (int m = 0; m < 4; ++m) { bf16_t* rowp = DX + (size_t)(row0 + ai * HALF + m * 16) * D + col0;
#pragma unroll
                for (int bj = 0; bj < 2; ++bj) { const f32x4 v0 = acc[ai][bj][m][0] * gv[bj][0], v1 = acc[ai][bj][m][1] * gv[bj][1];
                    u32x4 w; w.x = cvt_pk_bf16(v0[0], v0[1]); w.y = cvt_pk_bf16(v0[2], v0[3]); w.z = cvt_pk_bf16(v1[0], v1[1]); w.w = cvt_pk_bf16(v1[2], v1[3]);
                    *(u32x4*)(rowp + bj * HALF) = w; } }
    }
};
struct EpiSwiglu8 {
    static constexpr bool PERM = true;
    unsigned char* O; float scale;
    __device__ __forceinline__ void operator()(const Acc& acc, const Unit& u, int wr, int wc, int fr, int fq) const {
        const int row0 = u.pm * BM + wr * 64 + fr, col0 = (u.pn & 3) * HALF + wc * 32 + 8 * fq;
#pragma unroll
        for (int ai = 0; ai < 2; ++ai)
#pragma unroll
            for (int m = 0; m < 4; ++m) { unsigned char* rowp = O + (size_t)(row0 + ai * HALF + m * 16) * DE + col0;
                float o[8];
#pragma unroll
                for (int j = 0; j < 8; ++j) { const float gg = acc[ai][0][m][j >> 2][j & 3] * scale, uu = acc[ai][1][m][j >> 2][j & 3] * scale; o[j] = gg * sigmoidr_(gg) * uu * S8_ACT; }
                u32x2 w; w.x = (unsigned)pk4_fp8(o[0], o[1], o[2], o[3]); w.y = (unsigned)pk4_fp8(o[4], o[5], o[6], o[7]);
                *(u32x2*)rowp = w; }
    }
};
}

namespace att {
constexpr int DV = 128, NW = 8, QBLK = 32, KVBLK = 64;
#define SBAR() __builtin_amdgcn_sched_barrier(0)
__device__ __forceinline__ int crow(int r, int hi) { return (r & 3) + 8 * (r >> 2) + 4 * hi; }
template <int DQK> __device__ __forceinline__ int kswz(int row, int colB) { return row * (DQK * 2) + (colB ^ ((row & 7) << 4)); }

template <int DQK> struct Cst { static constexpr float SCALE = (DQK == 128 ? 0.088388347648318440f : 0.072168783648703220f) / (S8_QK * S8_QK); };

template <int DQK>
__device__ __forceinline__ void partialSM(f32x16& p0, f32x16& p1, float& m_reg, float& mn, float& alpha) {
  constexpr float SCALE = Cst<DQK>::SCALE, THR = 3.f;
  constexpr float C = SCALE * 1.4426950408889634f;
  float pmax = p0[0];
#pragma unroll
  for (int r = 1; r < 16; ++r) pmax = fmaxf(pmax, p0[r]);
#pragma unroll
  for (int r = 0; r < 16; ++r) pmax = fmaxf(pmax, p1[r]);
  { auto rr = __builtin_amdgcn_permlane32_swap(__float_as_uint(pmax), __float_as_uint(pmax), false, false);
    pmax = fmaxf(__uint_as_float(rr[0]), __uint_as_float(rr[1])); }
  if (__builtin_expect(__all(pmax - m_reg <= THR / SCALE), 1)) { mn = m_reg; alpha = 1.f; }
  else { mn = fmaxf(m_reg, pmax); alpha = __builtin_amdgcn_exp2f((m_reg - mn) * C); m_reg = mn; }
  float mnC = 4.0f - mn * C;
#pragma unroll
  for (int r = 0; r < 16; ++r) p0[r] = fmaf(p0[r], C, mnC);
#pragma unroll
  for (int r = 0; r < 16; ++r) p1[r] = fmaf(p1[r], C, mnC);
#pragma unroll
  for (int r = 0; r < 16; ++r) p0[r] = __builtin_amdgcn_exp2f(p0[r]);
}
__device__ __forceinline__ void finishSM(f32x16& p0, f32x16& p1, float alpha, float& l_reg, bf16x8& pa0, bf16x8& pa1, bf16x8& pa2, bf16x8& pa3) {
#pragma unroll
  for (int r = 0; r < 16; ++r) p1[r] = __builtin_amdgcn_exp2f(p1[r]);
  float ps = 0;
#pragma unroll
  for (int r = 0; r < 16; ++r) ps += p0[r];
#pragma unroll
  for (int r = 0; r < 16; ++r) ps += p1[r];
  { auto rr = __builtin_amdgcn_permlane32_swap(__float_as_uint(ps), __float_as_uint(ps), false, false);
    ps = __uint_as_float(rr[0]) + __uint_as_float(rr[1]); }
  l_reg = l_reg * alpha + ps;
#define PK4(P, BASE, OUT) do { unsigned a0 = cvt_pk_bf16(P[BASE + 0], P[BASE + 1]), a1 = cvt_pk_bf16(P[BASE + 2], P[BASE + 3]);   \
    unsigned b0 = cvt_pk_bf16(P[BASE + 4], P[BASE + 5]), b1 = cvt_pk_bf16(P[BASE + 6], P[BASE + 7]);                              \
    auto r0 = __builtin_amdgcn_permlane32_swap(a0, b0, false, false); auto r1 = __builtin_amdgcn_permlane32_swap(a1, b1, false, false); \
    u32x4 w = {r0[0], r1[0], r0[1], r1[1]}; OUT = *reinterpret_cast<bf16x8*>(&w); } while (0)
  PK4(p0, 0, pa0); PK4(p0, 8, pa1); PK4(p1, 0, pa2); PK4(p1, 8, pa3);
#undef PK4
}
typedef int v8i_a __attribute__((ext_vector_type(8)));
typedef int v4i_a __attribute__((ext_vector_type(4)));
template <int DQK> __device__ __forceinline__ int kpos(int pc, int k) { return DQK == 128 ? (pc ^ ((k >> 1) & 7)) : (pc ^ ((k >> 2) & 3)); }
template <int DQK>
__device__ __forceinline__ void qkt(f32x16& p0, f32x16& p1, const char* Ks, const v8i_a* qf, int r32, int hi) {
  p0 = f32x16{}; p1 = f32x16{};
#pragma unroll
  for (int ks = 0; ks < DQK / 64; ++ks) { const int pc = ks * 4 + hi * 2;
    const v4i_a a0 = *reinterpret_cast<const v4i_a*>(Ks + r32 * DQK + (kpos<DQK>(pc, r32) << 4)), a1 = *reinterpret_cast<const v4i_a*>(Ks + r32 * DQK + (kpos<DQK>(pc + 1, r32) << 4));
    const v4i_a c0 = *reinterpret_cast<const v4i_a*>(Ks + (32 + r32) * DQK + (kpos<DQK>(pc, 32 + r32) << 4)), c1 = *reinterpret_cast<const v4i_a*>(Ks + (32 + r32) * DQK + (kpos<DQK>(pc + 1, 32 + r32) << 4));
    const v8i_a k0 = __builtin_shufflevector(a0, a1, 0, 1, 2, 3, 4, 5, 6, 7), k1 = __builtin_shufflevector(c0, c1, 0, 1, 2, 3, 4, 5, 6, 7);
    p0 = __builtin_amdgcn_mfma_scale_f32_32x32x64_f8f6f4(k0, qf[ks], p0, 0, 0, 0, 0, 0, 0);
    p1 = __builtin_amdgcn_mfma_scale_f32_32x32x64_f8f6f4(k1, qf[ks], p1, 0, 0, 0, 0, 0, 0); }
}
__device__ __forceinline__ int v_st(int k, int c) { const int kk = (k & ~0xC) | ((k & 4) << 1) | ((k & 8) >> 1); return ((kk >> 3) * 4 + (c >> 5)) * 512 + ((kk & 7) * 32 + (c & 31)) * 2; }
__device__ __forceinline__ int v_rd_base(int lane) { return ((lane & 3) << 3) | (((lane >> 2) & 3) << 6) | (((lane >> 4) & 1) << 5) | (((lane >> 5) & 1) << 8); }
constexpr int v_rd_off(int d0, int ks, int half) { return d0 * 512 + ks * 4096 + half * 2048; }
template <int OFF> __device__ __forceinline__ s16x4 tr_read(int vb) {
  s16x4 r; asm volatile("ds_read_b64_tr_b16 %0, %1 offset:%2" : "=&v"(r) : "v"(vb), "i"(OFF) : "memory"); return r;
}
template <int D0> __device__ __forceinline__ void pv_one(f32x16& od, int vb, bf16x8 pa0, bf16x8 pa1, bf16x8 pa2, bf16x8 pa3) {
  const s16x4 l0 = tr_read<v_rd_off(D0, 0, 0)>(vb), h0 = tr_read<v_rd_off(D0, 0, 1)>(vb), l1 = tr_read<v_rd_off(D0, 1, 0)>(vb), h1 = tr_read<v_rd_off(D0, 1, 1)>(vb);
  const s16x4 l2 = tr_read<v_rd_off(D0, 2, 0)>(vb), h2 = tr_read<v_rd_off(D0, 2, 1)>(vb), l3 = tr_read<v_rd_off(D0, 3, 0)>(vb), h3 = tr_read<v_rd_off(D0, 3, 1)>(vb);
  asm volatile("s_waitcnt lgkmcnt(0)" ::: "memory"); SBAR();
#define PK(L, H) (bf16x8){L[0], L[1], L[2], L[3], H[0], H[1], H[2], H[3]}
  od = __builtin_amdgcn_mfma_f32_32x32x16_bf16(pa0, PK(l0, h0), od, 0, 0, 0);
  od = __builtin_amdgcn_mfma_f32_32x32x16_bf16(pa1, PK(l1, h1), od, 0, 0, 0);
  od = __builtin_amdgcn_mfma_f32_32x32x16_bf16(pa2, PK(l2, h2), od, 0, 0, 0);
  od = __builtin_amdgcn_mfma_f32_32x32x16_bf16(pa3, PK(l3, h3), od, 0, 0, 0);
#undef PK
}
__device__ __forceinline__ void pv_d0(f32x16* o, int vb, bf16x8 pa0, bf16x8 pa1, bf16x8 pa2, bf16x8 pa3) {
  pv_one<0>(o[0], vb, pa0, pa1, pa2, pa3); pv_one<1>(o[1], vb, pa0, pa1, pa2, pa3); pv_one<2>(o[2], vb, pa0, pa1, pa2, pa3); pv_one<3>(o[3], vb, pa0, pa1, pa2, pa3);
}

__device__ __forceinline__ void finishSM8(f32x16& p0, f32x16& p1, float alpha, float& l_reg, v8i_a& pf) {
#pragma unroll
  for (int r = 0; r < 16; ++r) p1[r] = __builtin_amdgcn_exp2f(p1[r]);
  float ps = 0;
#pragma unroll
  for (int r = 0; r < 16; ++r) ps += p0[r];
#pragma unroll
  for (int r = 0; r < 16; ++r) ps += p1[r];
  { auto rr = __builtin_amdgcn_permlane32_swap(__float_as_uint(ps), __float_as_uint(ps), false, false);
    ps = __uint_as_float(rr[0]) + __uint_as_float(rr[1]); }
  l_reg = l_reg * alpha + ps;
#pragma unroll
  for (int i = 0; i < 4; ++i) {
    unsigned d0 = (unsigned)__builtin_amdgcn_cvt_pk_fp8_f32(p0[4 * i], p0[4 * i + 1], 0, false); d0 = (unsigned)__builtin_amdgcn_cvt_pk_fp8_f32(p0[4 * i + 2], p0[4 * i + 3], (int)d0, true);
    unsigned d1 = (unsigned)__builtin_amdgcn_cvt_pk_fp8_f32(p1[4 * i], p1[4 * i + 1], 0, false); d1 = (unsigned)__builtin_amdgcn_cvt_pk_fp8_f32(p1[4 * i + 2], p1[4 * i + 3], (int)d1, true);
    auto rr = __builtin_amdgcn_permlane32_swap(d0, d1, false, false);
    pf[2 * i] = (int)rr[0]; pf[2 * i + 1] = (int)rr[1]; }
}
__device__ __forceinline__ void pv8(f32x16* o, const char* Vs, const v8i_a pf, int r32, int hi) {
  const int base = r32 * 64 + (((2 * hi) ^ ((r32 >> 2) & 3)) << 4);
#pragma unroll
  for (int d0 = 0; d0 < 4; ++d0) {
    const v4i_a lo = *reinterpret_cast<const v4i_a*>(Vs + base + d0 * 2048), hh = *reinterpret_cast<const v4i_a*>(Vs + (base ^ 16) + d0 * 2048);
    const v8i_a vf = __builtin_shufflevector(lo, hh, 0, 1, 2, 3, 4, 5, 6, 7);
    o[d0] = __builtin_amdgcn_mfma_scale_f32_32x32x64_f8f6f4(pf, vf, o[d0], 0, 0, 0, 0, 0, 0); }
}
constexpr int LDO = 1024;
template <int DQK, int SDEPTH>
__device__ __forceinline__ void attn_dense_body(const unsigned char* __restrict__ Qb, const unsigned char* __restrict__ Kh, const unsigned char* __restrict__ Vt, int vpitch,
                                                unsigned char* __restrict__ Ob, int seq, char* lds) {
  constexpr int SHM_V = KVBLK * DV, SHM_K = KVBLK * DQK, PPR = DQK / 16, NKC = (KVBLK * PPR + 511) / 512;
  const int tid = ltid(), wid = tid >> 6, lane = tid & 63, r32 = lane & 31, hi = lane >> 5;
  char* V_lds = lds; char* K_lds = lds + 2 * SHM_V;
  float* ws = (float*)(lds + 2 * SHM_V + 2 * SHM_K) + wid * 64; float* li_l = ws; float* al_l = ws + 32;
  float m_reg = -1e30f, l_reg = 0; f32x16 o[4] = {}; v8i_a qf[DQK / 64];
  const unsigned char* Qw = Qb + (long)(wid * QBLK + r32) * DQK + hi * 32;
#pragma unroll
  for (int ks = 0; ks < DQK / 64; ++ks) { const v4i_a lo = *reinterpret_cast<const v4i_a*>(Qw + ks * 64), hh = *reinterpret_cast<const v4i_a*>(Qw + ks * 64 + 16); qf[ks] = __builtin_shufflevector(lo, hh, 0, 1, 2, 3, 4, 5, 6, 7); }
  const int vd = tid >> 2, vpc = tid & 3, vst = vd * 64 + ((vpc ^ ((vd >> 2) & 3)) << 4);
  const unsigned char* Vsrc = Vt + (long)vd * vpitch + vpc * 16;
  struct { v4i_a vs; v4i_a ks[NKC]; } sr_[SDEPTH];
#define KID(q_) (tid + (q_) * 512)
#define KROW(q_) (KID(q_) / PPR)
#define KPC(q_) (KID(q_) % PPR)
#define KOK(q_) (NKC * 512 == KVBLK * PPR || (q_) + 1 < NKC || KID(q_) < KVBLK * PPR)
#define SLOAD(i, k0) do { sr_[i].vs = *reinterpret_cast<const v4i_a*>(Vsrc + (k0)); \
    _Pragma("unroll") for (int q_ = 0; q_ < NKC; ++q_) if (KOK(q_)) sr_[i].ks[q_] = *reinterpret_cast<const v4i_a*>(Kh + (long)((k0) + KROW(q_)) * DQK + KPC(q_) * 16); } while (0)
#define SWRITE(b, i) do { *(v4i_a*)(V_lds + (b) * SHM_V + vst) = sr_[i].vs; \
    _Pragma("unroll") for (int q_ = 0; q_ < NKC; ++q_) if (KOK(q_)) *(v4i_a*)(K_lds + (b) * SHM_K + KROW(q_) * DQK + (kpos<DQK>(KPC(q_), KROW(q_)) << 4)) = sr_[i].ks[q_]; } while (0)
#define SWAIT() do { if constexpr (SDEPTH == 2) { if constexpr (NKC == 1) asm volatile("s_waitcnt vmcnt(2)" ::: "memory"); else asm volatile("s_waitcnt vmcnt(3)" ::: "memory"); } \
    else asm volatile("s_waitcnt vmcnt(0)" ::: "memory"); } while (0)
#define RESC(a) do { if (__any((a) < 1.f)) { if (hi == 0) al_l[r32] = (a); asm volatile("s_waitcnt lgkmcnt(0)" ::: "memory"); \
    _Pragma("unroll") for (int d = 0; d < 4; ++d) _Pragma("unroll") for (int r = 0; r < 16; ++r) o[d][r] *= al_l[crow(r, hi)]; } } while (0)
#define QKT(P0, P1, KS) qkt<DQK>(P0, P1, KS, qf, r32, hi)
  f32x16 pA0, pA1, pB0, pB1; float mnA, mnB, alA, alB; v8i_a pf; const int NT = seq / KVBLK;
  constexpr int SE = 0, SO = SDEPTH - 1;
  SLOAD(SE, 0); asm volatile("s_waitcnt vmcnt(0)" ::: "memory"); SWRITE(0, SE); __syncthreads();
  QKT(pA0, pA1, K_lds); partialSM<DQK>(pA0, pA1, m_reg, mnA, alA);
  SLOAD(SO, KVBLK); if constexpr (SDEPTH == 2) { if (2 < NT) SLOAD(SE, 2 * KVBLK); }
  SWAIT(); SWRITE(1, SO); __syncthreads();
  for (int j = 1; j + 1 < NT; j += 2) {
    SBAR(); QKT(pB0, pB1, K_lds + SHM_K);
    finishSM8(pA0, pA1, alA, l_reg, pf); SBAR();
    SLOAD(SO, (j + SDEPTH) * KVBLK); SBAR();
    pv8(o, V_lds, pf, r32, hi); partialSM<DQK>(pB0, pB1, m_reg, mnB, alB);
    __syncthreads(); SWAIT(); SWRITE(0, SE);
    RESC(alB); __syncthreads();
    SBAR(); QKT(pA0, pA1, K_lds);
    finishSM8(pB0, pB1, alB, l_reg, pf); SBAR();
    if (SDEPTH == 1 || j + 3 < NT) SLOAD(SE, (j + 1 + SDEPTH) * KVBLK); SBAR();
    pv8(o, V_lds + SHM_V, pf, r32, hi); partialSM<DQK>(pA0, pA1, m_reg, mnA, alA);
    __syncthreads(); SWAIT(); SWRITE(1, SO);
    RESC(alA); __syncthreads();
  }
  SBAR(); QKT(pB0, pB1, K_lds + SHM_K);
  finishSM8(pA0, pA1, alA, l_reg, pf); SBAR();
  pv8(o, V_lds, pf, r32, hi); partialSM<DQK>(pB0, pB1, m_reg, mnB, alB);
  __syncthreads(); RESC(alB);
  finishSM8(pB0, pB1, alB, l_reg, pf); SBAR();
  pv8(o, V_lds + SHM_V, pf, r32, hi);
  if (hi == 0) li_l[r32] = l_reg; asm volatile("s_waitcnt lgkmcnt(0)" ::: "memory");
  float rli[16];
#pragma unroll
  for (int r = 0; r < 16; ++r) rli[r] = __builtin_amdgcn_rcpf(li_l[crow(r, hi)]) * (S8_Y / S8_V);
  unsigned char* Ow = Ob + (long)(wid * QBLK) * LDO;
#pragma unroll
  for (int r = 0; r < 16; ++r) { int orow = crow(r, hi);
#pragma unroll
    for (int d0 = 0; d0 < 4; ++d0) Ow[(long)orow * LDO + d0 * 32 + r32] = (unsigned char)(__builtin_amdgcn_cvt_pk_fp8_f32(o[d0][r] * rli[r], 0.f, 0, false) & 0xff); }
  asm volatile("s_waitcnt vmcnt(0) lgkmcnt(0)" ::: "memory"); __syncthreads();
#undef KID
#undef KROW
#undef KPC
#undef KOK
#undef SLOAD
#undef SWRITE
#undef SWAIT
#undef RESC
#undef QKT
}
#undef SBAR
}

constexpr size_t al256(size_t x) { return (x + 255) & ~(size_t)255; }
constexpr size_t WS_CTL   = 0;
constexpr size_t CTL_BYTES = 65536;
constexpr size_t CW_BAR = 0;
constexpr size_t CW_CNT = 4096;
constexpr size_t WS_MODV  = WS_CTL + CTL_BYTES;
constexpr size_t WS_WR    = WS_MODV + al256((size_t)2 * 5 * 12288 * 4);
constexpr size_t WS_ROPEA = WS_WR + (size_t)2 * 64 * 3 * 2 * 64 * 16;
constexpr size_t WS_ROPEC = WS_ROPEA + (size_t)4096 * 128 * 4;
constexpr size_t WS_W     = WS_ROPEC + (size_t)4096 * 64 * 4;
constexpr size_t WL_IN = 0, WL_UKV = WL_IN + (size_t)INCP * D * 2, WL_UQ = WL_UKV + (size_t)2048 * 256 * 2, WL_OA = WL_UQ + (size_t)1536 * 512 * 2,
                 WL_OB = WL_OA + (size_t)2048 * 1024 * 2, WL_OC = WL_OB + (size_t)2048 * 1024 * 2, WL_O = WL_OC + (size_t)2048 * 1024 * 2,
                 WL_GU = WL_O + (size_t)D * D * 2, WL_DN = WL_GU + (size_t)NE * 1024 * D * 2, WL_IN8 = WL_DN + (size_t)NE * D * DE * 2, WL_SIZE = WL_IN8 + (size_t)INCP * D;
constexpr int F8_LO = 9, F8_HI = 22; static_assert(F8_HI == G8_T0 && C_GL >= (G8_T0 - 1) * 256 && C_GL % 8 == 0, "gate-logit byte image");
constexpr size_t WS_X1    = WS_W + 2 * WL_SIZE;
constexpr size_t WS_X2    = WS_X1 + (size_t)MT * D * 4;
constexpr size_t WS_H     = WS_X2 + (size_t)MT * D * 4;
constexpr size_t WS_P     = WS_H + (size_t)MT * D * 2;
constexpr size_t WS_XS    = WS_P;
constexpr size_t WS_ACT   = WS_XS + (size_t)MAXSLOT * D * 2;
constexpr size_t WS_YS    = WS_ACT + (size_t)MAXSLOT * DE * 2;
static_assert(WS_YS + (size_t)MAXSLOT * D * 2 <= WS_P + (size_t)MT * INCP * 2, "MoE overlay must fit in P");
constexpr size_t WS_KA    = WS_P + (size_t)MT * INCP * 2;
constexpr size_t WS_VA    = WS_KA + (size_t)NB * 2 * LKV * 128 * 2;
constexpr size_t WS_QA    = WS_VA + (size_t)NB * 2 * LKV * 128 * 2;
constexpr size_t WS_CKVN  = WS_QA + (size_t)NB * 8 * LKV * 128 * 2;
constexpr size_t WS_CQN   = WS_CKVN + (size_t)MT * 256 * 2;
constexpr size_t WS_YCAT  = WS_CQN + (size_t)MT * 512 * 2;
constexpr size_t WS_KVUP  = WS_YCAT + (size_t)3 * MT * 1024 * 2;
constexpr size_t WS_QUP   = WS_KVUP + (size_t)MT * 2048 * 2;
constexpr size_t WS_KC    = WS_QUP + (size_t)MT * 1536 * 2;
constexpr size_t WS_QC    = WS_KC + (size_t)NB * 8 * LKV * 192 * 2;
constexpr size_t WS_VC    = WS_QC + (size_t)NB * 8 * LKV * 192 * 2;
constexpr size_t WS_M     = WS_VC + (size_t)NB * 8 * LKV * 128 * 2;
constexpr size_t WS_RTE   = WS_M + (size_t)MT * D * 2;
constexpr size_t WS_RTP   = WS_RTE + (size_t)MT * 2 * 4;
constexpr size_t WS_RTS   = WS_RTP + (size_t)MT * 2 * 4;
constexpr size_t WS_RTW   = WS_RTS + (size_t)MT * 2 * 4;
constexpr size_t WS_ELIST = WS_RTW + (size_t)MT * 2 * 4;
constexpr size_t WS_H8    = WS_ELIST + (size_t)NE * MT * 4;
constexpr size_t WS_END   = WS_H8 + (size_t)MT * D;

constexpr int LDS_STAGE = 131072, LDS_MISC = 2048, LDS_BYTES = LDS_STAGE + LDS_MISC;
constexpr int MISC_NBLK = 64, MISC_BLKE = 128, MISC_FBLK = 1024, MISC_ECNT = 1152, MISC_TMPB = 1280;

struct CvtJob { const float* src; bf16_t* dst; int K, N, Npad, batch, mode, tile0; float scale; int ld; };
constexpr int NJOBS = 22;
struct Params {
    const float* in[29];
    float* out;
    unsigned char* ws;
    CvtJob jobs[NJOBS];
    int total_tiles, ph_lo, ph_hi, tiles_l0;
};
enum { I_X = 0, I_C, I_CTX, I_CCTX, I_WMOD, I_BMOD, I_NORM1, I_NORM2, I_WIN, I_GQN, I_GKN, I_MQLN, I_WUQ, I_MKVLN, I_WUKV, I_MQN, I_MKN, I_CONVW, I_WOA, I_WOB, I_WOC,
       I_BGATE, I_WO, I_WGROUP, I_BGROUP, I_WROUTER, I_BROUTER, I_WGU, I_WDOWN };

__device__ __forceinline__ void cvt_tiles(const Params& P, LAS unsigned char* lds, int w0, int step, int wend) {
    const int tid = ltid();
    LAS float* tile = (LAS float*)lds;
    const int kk = tid >> 5, nn = (tid & 31) * 4;
    f32x4 ld[8];
    struct TJ { const float* src; bf16_t* dst; int K, N, ld, mode, k0, n0; float scale; };
    auto decode = [&](int w, TJ& t) {
        int j = 0;
#pragma unroll 1
        for (int q = 1; q < NJOBS; ++q) if (w >= P.jobs[q].tile0) j = q;
        const CvtJob jb = P.jobs[j];
        const int local = w - jb.tile0, tk_n = jb.K >> 7, tpm = tk_n * (jb.Npad >> 7);
        const int e = local / tpm, rem = local % tpm, tn = rem / tk_n, tk = rem % tk_n;
        t.ld = jb.ld; t.src = jb.src + (size_t)e * jb.K * jb.ld; t.dst = (jb.mode & 2) ? (bf16_t*)((unsigned char*)jb.dst + (size_t)e * jb.Npad * jb.K) : jb.dst + (size_t)e * jb.Npad * jb.K; t.scale = jb.scale; t.K = jb.K; t.N = jb.N; t.mode = jb.mode; t.k0 = tk * 128; t.n0 = tn * 128; };
    auto issue = [&](const TJ& t) {
#pragma unroll
        for (int p = 0; p < 8; ++p) { ld[p] = (f32x4){0.f, 0.f, 0.f, 0.f}; if (t.n0 + nn < t.N) ld[p] = *(const f32x4*)(t.src + (size_t)(t.k0 + kk + 16 * p) * t.ld + t.n0 + nn); } };
    TJ cur, nxt; int w = w0; bool have = w < wend;
    if (have) { decode(w, cur); issue(cur); }
    while (have) {
#pragma unroll
        for (int p = 0; p < 8; ++p) { LAS float* t = tile + (kk + 16 * p) * 129 + nn; t[0] = ld[p][0]; t[1] = ld[p][1]; t[2] = ld[p][2]; t[3] = ld[p][3]; }
        __syncthreads();
        const int wn = w + step; const bool hn = wn < wend;
        if (hn) { decode(wn, nxt); issue(nxt); }
        { const int nl = tid >> 2; const int n = cur.n0 + nl; int drow = n;
          if (cur.mode & 1) { const int jj = (n < DE) ? n : n - DE; drow = (jj >> 7) * 256 + ((n < DE) ? 0 : 128) + (jj & 127); }
          if (cur.mode & 2) { unsigned char* dp = (unsigned char*)cur.dst + (size_t)drow * cur.K + cur.k0; const float sc = cur.scale;
#pragma unroll
            for (int j = 0; j < 4; ++j) { const int kc = (tid & 3) * 8 + 32 * j; float v[8];
#pragma unroll
                for (int i = 0; i < 8; ++i) v[i] = tile[(kc + i) * 129 + nl] * sc;
                u32x2 o; o.x = (unsigned)pk4_fp8(v[0], v[1], v[2], v[3]); o.y = (unsigned)pk4_fp8(v[4], v[5], v[6], v[7]);
                *(u32x2*)(dp + kc) = o; }
          } else {
          bf16_t* dp = cur.dst + (size_t)drow * cur.K + cur.k0;
#pragma unroll
          for (int j = 0; j < 4; ++j) { const int kc = (tid & 3) * 8 + 32 * j; float v[8];
#pragma unroll
              for (int i = 0; i < 8; ++i) v[i] = tile[(kc + i) * 129 + nl];
              u32x4 o; o.x = cvt_pk_bf16(v[0], v[1]); o.y = cvt_pk_bf16(v[2], v[3]); o.z = cvt_pk_bf16(v[4], v[5]); o.w = cvt_pk_bf16(v[6], v[7]);
              *(u32x4*)(dp + kc) = o; } } }
        __syncthreads();
        cur = nxt; w = wn; have = hn;
    }
}

__device__ __forceinline__ void ph_prologue(const Params& P, LAS unsigned char* lds) {
    unsigned char* const ws = lptr(P.ws);
    const int tid = ltid(), G = gridDim.x, bx = blockIdx.x, lane = tid & 63, wid = tid >> 6;
    {
        float* ropeA = (float*)(ws + WS_ROPEA); float* ropeC = (float*)(ws + WS_ROPEC); float* WR = (float*)(ws + WS_WR);
        for (int i = bx * 512 + tid; i < SEQ * 64; i += G * 512) { const int s = i >> 6, a = i & 63; const float pos = (a < 32) ? (float)(s >> 6) : (float)(s & 63);
            const float inv = powf(10000.0f, -(float)(a & 31) / 32.0f); const float ang = pos * inv; ropeA[s * 128 + a] = cosf(ang); ropeA[s * 128 + 64 + a] = sinf(ang); }
        for (int i = bx * 512 + tid; i < SEQ * 32; i += G * 512) { const int s = i >> 5, a = i & 31; const float pos = (a < 16) ? (float)(s >> 6) : (float)(s & 63);
            const float inv = powf(10000.0f, -(float)(a & 15) / 16.0f); const float ang = pos * inv; ropeC[s * 64 + a] = cosf(ang); ropeC[s * 64 + 32 + a] = sinf(ang); }
        for (int i = bx * 512 + tid; i < 2 * 64 * 3 * 64 * 8; i += G * 512) {
            const int j = i & 7, ln = (i >> 3) & 63, t = i >> 9, nt = t % 3, ks = (t / 3) & 63, l = t / 192;
            const int k = ks * 32 + 8 * (ln >> 4) + j, o = nt * 16 + (ln & 15);
            float v = 0.f; if (o < 32) v = P.in[I_WROUTER][((size_t)l * D + k) * NE + o]; else if (o < 36) v = P.in[I_WGROUP][((size_t)l * D + k) * 4 + (o - 32)];
            const unsigned hb = cvt_pk_bf16(v, 0.f) & 0xffffu, lb = cvt_pk_bf16(v - __uint_as_float(hb << 16), 0.f) & 0xffffu;
            bf16_t* wr = (bf16_t*)WR + ((size_t)((l * 64 + ks) * 3 + nt) * 2 * 64 + ln) * 8 + j;
            wr[0] = (bf16_t)hb; wr[64 * 8] = (bf16_t)lb; }
    }
    if (bx < 192) {
        const int l = bx / 96, cg = bx % 96, c4 = lane & 31, ksub = lane >> 5;
        LAS float* actL = (LAS float*)lds; LAS float* red = (LAS float*)(lds + 40960);
        for (int i = tid; i < 5 * D; i += 512) { const int r = i / D, k = i % D; const float v = (r < 4) ? P.in[I_C][r * D + k] : P.in[I_CCTX][k]; actL[i] = v / (1.0f + __expf(-v)); }
        __syncthreads();
        f32x4 acc[5];
#pragma unroll
        for (int r = 0; r < 5; ++r) acc[r] = (f32x4){0.f, 0.f, 0.f, 0.f};
        const float* wp = P.in[I_WMOD] + ((size_t)l * D + wid * 256 + ksub) * 12288 + cg * 128 + c4 * 4; const LAS float* ap = actL + wid * 256 + ksub;
        f32x4 wv[8], wn[8];
#pragma unroll
        for (int q = 0; q < 8; ++q) wv[q] = *(const f32x4*)(wp + (size_t)q * 2 * 12288);
        for (int j = 0; j < 128; j += 8) {
            if (j + 8 < 128) {
#pragma unroll
                for (int q = 0; q < 8; ++q) wn[q] = *(const f32x4*)(wp + (size_t)(j + 8 + q) * 2 * 12288); }
            __builtin_amdgcn_sched_barrier(0);
#pragma unroll
            for (int q = 0; q < 8; ++q)
#pragma unroll
                for (int r = 0; r < 5; ++r) acc[r] += ap[r * D + (j + q) * 2] * wv[q];
#pragma unroll
            for (int q = 0; q < 8; ++q) wv[q] = wn[q];
        }
#pragma unroll
        for (int r = 0; r < 5; ++r) *(LAS f32x4*)(red + ((wid * 2 + ksub) * 5 + r) * 128 + c4 * 4) = acc[r];
        __syncthreads();
        float* modv = (float*)(ws + WS_MODV);
        for (int i = tid; i < 5 * 128; i += 512) { const int r = i >> 7, cc = i & 127; float sum = 0.f;
#pragma unroll
            for (int w = 0; w < 16; ++w) sum += red[(w * 5 + r) * 128 + cc];
            modv[((size_t)l * 5 + r) * 12288 + cg * 128 + cc] = sum + P.in[I_BMOD][l * 12288 + cg * 128 + cc]; }
        __syncthreads();
    }
    cvt_tiles(P, lds, bx, G, P.tiles_l0);
}

template <bool TO_LDS, bool WBF, bool W8> __device__ __forceinline__ void norm_mod_store(const f32x4 (&xv)[8], const float* gain, const float* sc, const float* sh, bf16_t* hrow, unsigned char* h8row, LAS float* lrow, int lane) {
    float ss = 0.f;
#pragma unroll
    for (int i = 0; i < 8; ++i) ss += xv[i][0] * xv[i][0] + xv[i][1] * xv[i][1] + xv[i][2] * xv[i][2] + xv[i][3] * xv[i][3];
    ss = wave_sum(ss);
    const float rs = 1.0f / sqrtf(ss * (1.0f / D) + EPS);
#pragma unroll
    for (int i = 0; i < 8; ++i) { const int c = i * 256 + lane * 4;
        const f32x4 g = *(const f32x4*)(gain + c), s1 = *(const f32x4*)(sc + c), s0 = *(const f32x4*)(sh + c);
        const f32x4 y = (xv[i] * rs) * g * (s1 + 1.0f) + s0;
        if constexpr (WBF) { u32x2 w; w.x = cvt_pk_bf16(y[0], y[1]); w.y = cvt_pk_bf16(y[2], y[3]); *(u32x2*)(hrow + c) = w; }
        if constexpr (W8) *(int*)(h8row + c) = pk4_fp8(y[0] * S8_H, y[1] * S8_H, y[2] * S8_H, y[3] * S8_H);
        if constexpr (TO_LDS) *(LAS f32x4*)(lrow + c) = y; }
}
struct ModVec { f32x4 a[8], b[8]; };
__device__ __forceinline__ void modvec_load(ModVec& m, const float* gain, const float* sc, const float* sh, int lane) {
#pragma unroll
    for (int i = 0; i < 8; ++i) { const int c = i * 256 + lane * 4; m.a[i] = *(const f32x4*)(gain + c) * (*(const f32x4*)(sc + c) + 1.0f); m.b[i] = *(const f32x4*)(sh + c); }
}
template <bool TO_LDS, bool WBF, bool W8> __device__ __forceinline__ void norm_mod_store2(const f32x4 (&xv)[8], const ModVec& m, bf16_t* hrow, unsigned char* h8row, LAS float* lrow, int lane) {
    float ss = 0.f;
#pragma unroll
    for (int i = 0; i < 8; ++i) ss += xv[i][0] * xv[i][0] + xv[i][1] * xv[i][1] + xv[i][2] * xv[i][2] + xv[i][3] * xv[i][3];
    ss = wave_sum(ss);
    const float rs = 1.0f / sqrtf(ss * (1.0f / D) + EPS);
#pragma unroll
    for (int i = 0; i < 8; ++i) { const int c = i * 256 + lane * 4;
        const f32x4 y = (xv[i] * rs) * m.a[i] + m.b[i];
        if constexpr (WBF) { u32x2 w; w.x = cvt_pk_bf16(y[0], y[1]); w.y = cvt_pk_bf16(y[2], y[3]); *(u32x2*)(hrow + c) = w; }
        if constexpr (W8) *(int*)(h8row + c) = pk4_fp8(y[0] * S8_H, y[1] * S8_H, y[2] * S8_H, y[3] * S8_H);
        if constexpr (TO_LDS) *(LAS f32x4*)(lrow + c) = y; }
}
__device__ __forceinline__ int row_rb(int r) { return r < TX ? (r >> 12) : NB; }

__device__ __forceinline__ const float* xin_row(const Params& P, const unsigned char* ws, int l, int r) {
    return (l == 0) ? ((r < TX) ? P.in[I_X] + (size_t)r * D : P.in[I_CTX] + (size_t)(r - TX) * D) : (const float*)(ws + WS_X2) + (size_t)r * D; }
__device__ __forceinline__ void ph_norm_in(const Params& P, int nrows) {
    unsigned char* const ws = lptr(P.ws);
    const int tid = ltid(), lane = tid & 63, wid = tid >> 6, G = gridDim.x;
    const float* modv = (const float*)(ws + WS_MODV); bf16_t* H = (bf16_t*)(ws + WS_H);
    const int per = (nrows + G - 1) / G, r0 = blockIdx.x * per, r1 = (r0 + per < nrows) ? r0 + per : nrows;
    ModVec mv; int cur = -1;
    for (int r = r0 + wid; r < r1; r += 8) {
        const int rb = row_rb(r);
        if (rb != cur) { const float* m = modv + (size_t)rb * 12288; modvec_load(mv, P.in[I_NORM1], m + 2048, m, lane); cur = rb; }
        const float* xr = (r < TX) ? P.in[I_X] + (size_t)r * D : P.in[I_CTX] + (size_t)(r - TX) * D;
        f32x4 xv[8];
#pragma unroll
        for (int i = 0; i < 8; ++i) xv[i] = *(const f32x4*)(xr + i * 256 + lane * 4);
        norm_mod_store2<false, true, true>(xv, mv, H + (size_t)r * D, (unsigned char*)(ws + WS_H8) + (size_t)r * D, (LAS float*)nullptr, lane);
    }
}

__device__ __forceinline__ float swz_xor1(float v) { return __int_as_float(__builtin_amdgcn_ds_swizzle(__float_as_int(v), 0x041F)); }
__device__ __forceinline__ float swz_xor2(float v) { return __int_as_float(__builtin_amdgcn_ds_swizzle(__float_as_int(v), 0x081F)); }
__device__ __forceinline__ float swz_xor4(float v) { return __int_as_float(__builtin_amdgcn_ds_swizzle(__float_as_int(v), 0x101F)); }
__device__ __forceinline__ void head128_norm_rope(const bf16_t* __restrict__ src, const float* __restrict__ gain, const float* __restrict__ rope, unsigned char* __restrict__ dst, int j, bool do_store) {
    const u32x4 w0 = *(const u32x4*)(src + j * 16), w1 = *(const u32x4*)(src + j * 16 + 8);
    float v[16];
#pragma unroll
    for (int i = 0; i < 4; ++i) { v[2 * i] = BF_LO(w0[i]); v[2 * i + 1] = BF_HI(w0[i]); v[8 + 2 * i] = BF_LO(w1[i]); v[9 + 2 * i] = BF_HI(w1[i]); }
    float ss = 0.f;
#pragma unroll
    for (int i = 0; i < 16; ++i) ss += v[i] * v[i];
    ss += swz_xor1(ss); ss += swz_xor2(ss); ss += swz_xor4(ss);
    const float rs = 1.0f / sqrtf(ss * (1.0f / 128.0f) + EPS);
#pragma unroll
    for (int q = 0; q < 4; ++q) { const f32x4 g = *(const f32x4*)(gain + j * 16 + q * 4);
#pragma unroll
        for (int i = 0; i < 4; ++i) v[q * 4 + i] *= rs * g[i]; }
    if (rope) { const int idx0 = (j & 3) * 16; const bool first = j < 4;
#pragma unroll
        for (int q = 0; q < 4; ++q) { const f32x4 cs = *(const f32x4*)(rope + idx0 + q * 4), sn = *(const f32x4*)(rope + 64 + idx0 + q * 4);
#pragma unroll
            for (int i = 0; i < 4; ++i) { const float y = v[q * 4 + i], yp = swz_xor4(y); v[q * 4 + i] = first ? (y * cs[i] - yp * sn[i]) : (y * cs[i] + yp * sn[i]); } } }
    if (do_store) { u32x4 o;
#pragma unroll
        for (int i = 0; i < 4; ++i) o[i] = (unsigned)pk4_fp8(v[4 * i] * S8_QK, v[4 * i + 1] * S8_QK, v[4 * i + 2] * S8_QK, v[4 * i + 3] * S8_QK);
        *(u32x4*)(dst + j * 16) = o; }
}
__device__ __forceinline__ void vt_tiles(const bf16_t* __restrict__ src, int ld, int colbase, int colstride, int nh, unsigned char* __restrict__ dst, LAS unsigned char* lds) {
    const int tid = ltid(), G = gridDim.x, per = nh * (LKV / 64), NT = NB * per;
    const int key = tid >> 3, dch = (tid & 7) * 16;
    auto tile_src = [&](int t) { const int b = t / per, rem = t % per, h = rem / (LKV / 64), key0 = (rem % (LKV / 64)) * 64; const int row0 = (key0 < CL) ? TX + b * CL + key0 : b * SEQ + key0 - CL;
        return src + (size_t)(row0 + key) * ld + colbase + h * colstride + dch; };
    u32x4 w0 = (u32x4){0u, 0u, 0u, 0u}, w1 = w0;
    if ((int)blockIdx.x < NT) { const bf16_t* p = tile_src(blockIdx.x); w0 = *(const u32x4*)p; w1 = *(const u32x4*)(p + 8); }
    for (int t = blockIdx.x; t < NT; t += G) {
        const int b = t / per, rem = t % per, h = rem / (LKV / 64), key0 = (rem % (LKV / 64)) * 64;
        { u32x4 o;
          o.x = (unsigned)pk4_fp8(BF_LO(w0.x) * S8_V, BF_HI(w0.x) * S8_V, BF_LO(w0.y) * S8_V, BF_HI(w0.y) * S8_V); o.y = (unsigned)pk4_fp8(BF_LO(w0.z) * S8_V, BF_HI(w0.z) * S8_V, BF_LO(w0.w) * S8_V, BF_HI(w0.w) * S8_V);
          o.z = (unsigned)pk4_fp8(BF_LO(w1.x) * S8_V, BF_HI(w1.x) * S8_V, BF_LO(w1.y) * S8_V, BF_HI(w1.y) * S8_V); o.w = (unsigned)pk4_fp8(BF_LO(w1.z) * S8_V, BF_HI(w1.z) * S8_V, BF_LO(w1.w) * S8_V, BF_HI(w1.w) * S8_V);
          *(LAS u32x4*)(lds + key * 144 + dch) = o; }
        if (t + G < NT) { const bf16_t* p = tile_src(t + G); w0 = *(const u32x4*)p; w1 = *(const u32x4*)(p + 8); }
        __syncthreads();
        { const int d = tid >> 2, kc = (tid & 3) * 16; u32x4 o;
#pragma unroll
          for (int q = 0; q < 4; ++q) { unsigned w = 0;
#pragma unroll
              for (int i = 0; i < 4; ++i) w |= (unsigned)lds[(kc + q * 4 + i) * 144 + d] << (8 * i);
              o[q] = w; }
          *(u32x4*)(dst + ((size_t)(b * nh + h) * 128 + d) * LKV + key0 + kc) = o; }
        __syncthreads();
    }
}
__device__ __forceinline__ void head128_core(const u32x4 w0, const u32x4 w1, const f32x4 (&g)[4], const f32x4 (&cs)[4], const f32x4 (&sn)[4], bool use_rope, int j, float (&v)[16]) {
#pragma unroll
    for (int i = 0; i < 4; ++i) { v[2 * i] = BF_LO(w0[i]); v[2 * i + 1] = BF_HI(w0[i]); v[8 + 2 * i] = BF_LO(w1[i]); v[9 + 2 * i] = BF_HI(w1[i]); }
    float ss = 0.f;
#pragma unroll
    for (int i = 0; i < 16; ++i) ss += v[i] * v[i];
    ss += swz_xor1(ss); ss += swz_xor2(ss); ss += swz_xor4(ss);
    const float rs = 1.0f / sqrtf(ss * (1.0f / 128.0f) + EPS);
#pragma unroll
    for (int q = 0; q < 4; ++q)
#pragma unroll
        for (int i = 0; i < 4; ++i) v[q * 4 + i] *= rs * g[q][i];
    const bool first = j < 4;
#pragma unroll
    for (int q = 0; q < 4; ++q)
#pragma unroll
        for (int i = 0; i < 4; ++i) { const float y = v[q * 4 + i], yp = swz_xor4(y); const float ro = first ? (y * cs[q][i] - yp * sn[q][i]) : (y * cs[q][i] + yp * sn[q][i]); v[q * 4 + i] = use_rope ? ro : y; }
}
__device__ __forceinline__ void post_in_row(const bf16_t* __restrict__ pr, unsigned char* __restrict__ KA, unsigned char* __restrict__ QA, unsigned char* __restrict__ CKVN, unsigned char* __restrict__ CQN,
                                            bf16_t* __restrict__ YB, const float* __restrict__ ropeA, const float* __restrict__ gk, const float* __restrict__ gq, const float* __restrict__ gkv,
                                            const float* __restrict__ gcq, const float (&cwr)[2][3][8], int r, int Mq, int lane) {
    const bool isx = r < TX; const int b = isx ? (r >> 12) : ((r - TX) >> 8); const int s = isx ? (r & (SEQ - 1)) : ((r - TX) & (CL - 1));
    const int key = isx ? CL + s : s, qrow = isx ? s : SEQ + s;
    const int j = lane & 7, hk = (lane >> 3) & 1, hq = lane >> 3;
    const int slen = isx ? SEQ : CL; const bool hasp = s > 0, hasn = s < slen - 1;
    const u32x4 k0 = *(const u32x4*)(pr + C_K + hk * 128 + j * 16), k1 = *(const u32x4*)(pr + C_K + hk * 128 + j * 16 + 8);
    const u32x4 q0 = *(const u32x4*)(pr + C_Q + hq * 128 + j * 16), q1 = *(const u32x4*)(pr + C_Q + hq * 128 + j * 16 + 8);
    const u32x2 wkv = *(const u32x2*)(pr + C_CKV + lane * 4);
    const u32x4 wcq = *(const u32x4*)(pr + C_CQ + lane * 8);
    u32x4 xc[2], gc[2], gb[2], xp[2], gp[2], xn[2], gn[2];
#define PI_CONV_LOAD(p) do { const int c_ = (p) * 512 + lane * 8; \
        xc[p] = *(const u32x4*)(pr + C_XB + c_); gc[p] = *(const u32x4*)(pr + C_GC + c_); gb[p] = *(const u32x4*)(pr + C_GB + c_); \
        xp[p] = *(const u32x4*)(pr - INCP + C_XB + c_); gp[p] = *(const u32x4*)(pr - INCP + C_GC + c_); \
        xn[p] = *(const u32x4*)(pr + INCP + C_XB + c_); gn[p] = *(const u32x4*)(pr + INCP + C_GC + c_); } while (0)
    PI_CONV_LOAD(0);
    const float* rope = ropeA + (size_t)(isx ? s : 0) * 128 + (j & 3) * 16;
    f32x4 cs[4], sn[4], gkr[4], gqr[4];
#pragma unroll
    for (int q = 0; q < 4; ++q) { cs[q] = *(const f32x4*)(rope + q * 4); sn[q] = *(const f32x4*)(rope + 64 + q * 4); gkr[q] = *(const f32x4*)(gk + j * 16 + q * 4); gqr[q] = *(const f32x4*)(gq + j * 16 + q * 4); }
    const f32x4 gkv4 = *(const f32x4*)(gkv + lane * 4), gc0 = *(const f32x4*)(gcq + lane * 8), gc1 = *(const f32x4*)(gcq + lane * 8 + 4);
    __builtin_amdgcn_sched_barrier(0);
    { float v[16]; head128_core(k0, k1, gkr, cs, sn, isx, j, v);
      if (lane < 16) { u32x4 o;
#pragma unroll
          for (int i = 0; i < 4; ++i) o[i] = (unsigned)pk4_fp8(v[4 * i] * S8_QK, v[4 * i + 1] * S8_QK, v[4 * i + 2] * S8_QK, v[4 * i + 3] * S8_QK);
          *(u32x4*)(KA + ((size_t)(b * 2 + hk) * LKV + key) * 128 + j * 16) = o; } }
    { const float v0 = BF_LO(wkv.x), v1 = BF_HI(wkv.x), v2 = BF_LO(wkv.y), v3 = BF_HI(wkv.y);
      const float ss = wave_sum(v0 * v0 + v1 * v1 + v2 * v2 + v3 * v3); const float rs = 1.0f / sqrtf(ss * (1.0f / 256.0f) + EPS);
      *(int*)(CKVN + (size_t)r * 256 + lane * 4) = pk4_fp8(v0 * rs * gkv4[0] * S8_H, v1 * rs * gkv4[1] * S8_H, v2 * rs * gkv4[2] * S8_H, v3 * rs * gkv4[3] * S8_H); }
    __builtin_amdgcn_sched_barrier(0);
    PI_CONV_LOAD(1);
#undef PI_CONV_LOAD
    __builtin_amdgcn_sched_barrier(0);
    if (r < Mq) {
        { float v[16]; head128_core(q0, q1, gqr, cs, sn, isx, j, v); u32x4 o;
#pragma unroll
          for (int i = 0; i < 4; ++i) o[i] = (unsigned)pk4_fp8(v[4 * i] * S8_QK, v[4 * i + 1] * S8_QK, v[4 * i + 2] * S8_QK, v[4 * i + 3] * S8_QK);
          *(u32x4*)(QA + ((size_t)(b * 8 + hq) * LKV + qrow) * 128 + j * 16) = o; }
        { float v[8];
#pragma unroll
          for (int i = 0; i < 4; ++i) { v[2 * i] = BF_LO(wcq[i]); v[2 * i + 1] = BF_HI(wcq[i]); }
          float ss = 0.f;
#pragma unroll
          for (int i = 0; i < 8; ++i) ss += v[i] * v[i];
          ss = wave_sum(ss); const float rs = 1.0f / sqrtf(ss * (1.0f / 512.0f) + EPS);
          u32x2 o; o.x = (unsigned)pk4_fp8(v[0] * rs * gc0[0] * S8_H, v[1] * rs * gc0[1] * S8_H, v[2] * rs * gc0[2] * S8_H, v[3] * rs * gc0[3] * S8_H);
          o.y = (unsigned)pk4_fp8(v[4] * rs * gc1[0] * S8_H, v[5] * rs * gc1[1] * S8_H, v[6] * rs * gc1[2] * S8_H, v[7] * rs * gc1[3] * S8_H);
          *(u32x2*)(CQN + (size_t)r * 512 + lane * 8) = o; }
#pragma unroll
        for (int p = 0; p < 2; ++p) { const int c = p * 512 + lane * 8;
            if (!hasp) { xp[p] = (u32x4){0u, 0u, 0u, 0u}; gp[p] = xp[p]; }
            if (!hasn) { xn[p] = (u32x4){0u, 0u, 0u, 0u}; gn[p] = xn[p]; }
            float o[8];
#pragma unroll
            for (int i = 0; i < 8; ++i) {
#define BFH(W, J) __uint_as_float(((J) & 1) ? ((W)[(J) >> 1] & 0xffff0000u) : ((W)[(J) >> 1] << 16))
                const float zc = BFH(xc[p], i) * BFH(gc[p], i), zp = BFH(xp[p], i) * BFH(gp[p], i), zn = BFH(xn[p], i) * BFH(gn[p], i);
                o[i] = BFH(gb[p], i) * (cwr[p][0][i] * zp + cwr[p][1][i] * zc + cwr[p][2][i] * zn); }
#undef BFH
            u32x4 w; w.x = cvt_pk_bf16(o[0], o[1]); w.y = cvt_pk_bf16(o[2], o[3]); w.z = cvt_pk_bf16(o[4], o[5]); w.w = cvt_pk_bf16(o[6], o[7]);
            *(u32x4*)(YB + (size_t)r * 1024 + c) = w; }
    }
}
__device__ __forceinline__ void ph_post_in(const Params& P, int l, int Mq, LAS unsigned char* lds) {
    unsigned char* const ws = lptr(P.ws);
    const int tid = ltid(), lane = tid & 63, wid = tid >> 6, G = gridDim.x;
    const bf16_t* Pb = (const bf16_t*)(ws + WS_P);
    unsigned char* KA = (unsigned char*)(ws + WS_KA); unsigned char* QA = (unsigned char*)(ws + WS_QA);
    unsigned char* CKVN = (unsigned char*)(ws + WS_CKVN); unsigned char* CQN = (unsigned char*)(ws + WS_CQN); bf16_t* YB = (bf16_t*)(ws + WS_YCAT) + (size_t)MT * 1024;
    const float* ropeA = (const float*)(ws + WS_ROPEA);
    const float* gk = P.in[I_GKN] + l * 128; const float* gq = P.in[I_GQN] + l * 128;
    const float* gkv = P.in[I_MKVLN] + l * 256; const float* gcq = P.in[I_MQLN] + l * 512; const float* cw = P.in[I_CONVW] + (size_t)l * 3 * 1024;
    float cwr[2][3][8];
#pragma unroll
    for (int p = 0; p < 2; ++p)
#pragma unroll
        for (int q = 0; q < 3; ++q) { const f32x4 a = *(const f32x4*)(cw + q * 1024 + p * 512 + lane * 8), b2 = *(const f32x4*)(cw + q * 1024 + p * 512 + lane * 8 + 4);
#pragma unroll
            for (int j = 0; j < 4; ++j) { cwr[p][q][j] = a[j]; cwr[p][q][4 + j] = b2[j]; } }
    const int per = (MT + G - 1) / G, rb0 = blockIdx.x * per, rb1 = (rb0 + per < MT) ? rb0 + per : MT;
    for (int r = rb0 + wid; r < rb1; r += 8) post_in_row(Pb + (size_t)r * INCP, KA, QA, CKVN, CQN, YB, ropeA, gk, gq, gkv, gcq, cwr, r, Mq, lane);
    vt_tiles(Pb + C_V, INCP, 0, 128, 2, (unsigned char*)(ws + WS_VA), lds);
}

__device__ __forceinline__ void mla192_norm_rope(const bf16_t* nope, const bf16_t* ropesrc, const float* gain, const float* rope  , unsigned char* dst, int j) {
    const u32x4 w0 = *(const u32x4*)(nope + j * 16), w1 = *(const u32x4*)(nope + j * 16 + 8), w2 = *(const u32x4*)(ropesrc + j * 8);
    float v[16], t[8];
#pragma unroll
    for (int i = 0; i < 4; ++i) { v[2 * i] = BF_LO(w0[i]); v[2 * i + 1] = BF_HI(w0[i]); v[8 + 2 * i] = BF_LO(w1[i]); v[9 + 2 * i] = BF_HI(w1[i]); t[2 * i] = BF_LO(w2[i]); t[2 * i + 1] = BF_HI(w2[i]); }
    float ss = 0.f;
#pragma unroll
    for (int i = 0; i < 16; ++i) ss += v[i] * v[i];
#pragma unroll
    for (int i = 0; i < 8; ++i) ss += t[i] * t[i];
    ss += swz_xor1(ss); ss += swz_xor2(ss); ss += swz_xor4(ss);
    const float rs = 1.0f / sqrtf(ss * (1.0f / 192.0f) + EPS);
#pragma unroll
    for (int q = 0; q < 4; ++q) { const f32x4 g = *(const f32x4*)(gain + j * 16 + q * 4);
#pragma unroll
        for (int i = 0; i < 4; ++i) v[q * 4 + i] *= rs * g[i]; }
#pragma unroll
    for (int q = 0; q < 2; ++q) { const f32x4 g = *(const f32x4*)(gain + 128 + j * 8 + q * 4);
#pragma unroll
        for (int i = 0; i < 4; ++i) t[q * 4 + i] *= rs * g[i]; }
    if (rope) { const int idx0 = (j & 3) * 8; const bool first = j < 4;
#pragma unroll
        for (int q = 0; q < 2; ++q) { const f32x4 cs = *(const f32x4*)(rope + idx0 + q * 4), sn = *(const f32x4*)(rope + 32 + idx0 + q * 4);
#pragma unroll
            for (int i = 0; i < 4; ++i) { const float y = t[q * 4 + i], yp = swz_xor4(y); t[q * 4 + i] = first ? (y * cs[i] - yp * sn[i]) : (y * cs[i] + yp * sn[i]); } } }
    u32x4 o; u32x2 o2;
#pragma unroll
    for (int i = 0; i < 4; ++i) o[i] = (unsigned)pk4_fp8(v[4 * i] * S8_QK, v[4 * i + 1] * S8_QK, v[4 * i + 2] * S8_QK, v[4 * i + 3] * S8_QK);
    o2.x = (unsigned)pk4_fp8(t[0] * S8_QK, t[1] * S8_QK, t[2] * S8_QK, t[3] * S8_QK); o2.y = (unsigned)pk4_fp8(t[4] * S8_QK, t[5] * S8_QK, t[6] * S8_QK, t[7] * S8_QK);
    *(u32x4*)(dst + j * 16) = o; *(u32x2*)(dst + 128 + j * 8) = o2;
}
__device__ __forceinline__ void ph_post_up(const Params& P, int l, int Mq, LAS unsigned char* lds) {
    unsigned char* const ws = lptr(P.ws);
    const int tid = ltid(), lane = tid & 63, wid = tid >> 6, G = gridDim.x, hh = lane >> 3, j = lane & 7;
    const bf16_t* Pb = (const bf16_t*)(ws + WS_P); const bf16_t* KVUP = (const bf16_t*)(ws + WS_KVUP); const bf16_t* QUP = (const bf16_t*)(ws + WS_QUP);
    unsigned char* KC = (unsigned char*)(ws + WS_KC); unsigned char* QC = (unsigned char*)(ws + WS_QC);
    const float* ropeC = (const float*)(ws + WS_ROPEC);
    const float* gk = P.in[I_MKN] + l * 192; const float* gq = P.in[I_MQN] + l * 192;
    const int per = (MT + G - 1) / G, rb0 = blockIdx.x * per, rb1 = (rb0 + per < MT) ? rb0 + per : MT;
    for (int r = rb0 + wid; r < rb1; r += 8) {
        const bool isx = r < TX; const int b = isx ? (r >> 12) : ((r - TX) >> 8); const int s_ = isx ? (r & (SEQ - 1)) : ((r - TX) & (CL - 1));
        const int key = isx ? CL + s_ : s_, qrow = isx ? s_ : SEQ + s_;
        const float* rope = isx ? ropeC + (size_t)s_ * 64 : nullptr;
        const bf16_t* kvr = KVUP + (size_t)r * 2048 + hh * 256; const bf16_t* krp = Pb + (size_t)r * INCP + C_KR;
        mla192_norm_rope(kvr, krp, gk, rope, KC + ((size_t)(b * 8 + hh) * LKV + key) * 192, j);
        if (r < Mq) { const bf16_t* qr = QUP + (size_t)r * 1536 + hh * 192;
            mla192_norm_rope(qr, qr + 128, gq, rope, QC + ((size_t)(b * 8 + hh) * LKV + qrow) * 192, j); }
    }
    vt_tiles(KVUP + 128, 2048, 0, 256, 8, (unsigned char*)(ws + WS_VC), lds);
}

__device__ __forceinline__ void ph_attention(const Params& P, int l, char* lds_g, int vcu) {
    unsigned char* const ws = lptr(P.ws);
    const unsigned char* KA = (const unsigned char*)(ws + WS_KA); const unsigned char* VA = (const unsigned char*)(ws + WS_VA); const unsigned char* QA = (const unsigned char*)(ws + WS_QA);
    const unsigned char* KC = (const unsigned char*)(ws + WS_KC); const unsigned char* QC = (const unsigned char*)(ws + WS_QC); const unsigned char* VC = (const unsigned char*)(ws + WS_VC);
    unsigned char* YA = (unsigned char*)(ws + WS_YCAT); unsigned char* YC = YA + (size_t)2 * MT * 1024 * 2;
    const int G = gridDim.x, nun = (l == 0) ? 544 : 512;
#ifndef NO_GQA
#ifndef MK_DUP_GQA
#define MK_DUP_GQA 0
#endif
#pragma unroll 1
    for (int rep2 = 0; rep2 <= MK_DUP_GQA; ++rep2)
#pragma unroll 1
    for (int u = vcu; u < nun; u += G) {
        int b, h, qrow0, orow0, seq;
        if (u < 512) { const int gi = u >> 6; b = gi >> 1; h = (gi & 1) * 4 + ((u >> 4) & 3); const int qb = u & 15; qrow0 = qb * 256; orow0 = b * SEQ + qb * 256; seq = LKV; }
        else { const int bh = u - 512; b = bh >> 3; h = bh & 7; qrow0 = SEQ; orow0 = TX + b * CL; seq = CL; }
        const int kvh = h >> 2;
        att::attn_dense_body<128, 2>(QA + ((size_t)(b * 8 + h) * LKV + qrow0) * 128, KA + (size_t)(b * 2 + kvh) * LKV * 128, VA + (size_t)(b * 2 + kvh) * 128 * LKV, LKV,
                                     YA + (size_t)orow0 * 1024 + h * 128, seq, lds_g);
    }
#endif
#ifndef NO_MLA
#ifndef MK_DUP_MLA
#define MK_DUP_MLA 0
#endif
#pragma unroll 1
    for (int rep2 = 0; rep2 <= MK_DUP_MLA; ++rep2)
#pragma unroll 1
    for (int u = vcu; u < nun; u += G) {
        int bh, qrow0, orow0, seq;
        if (u < 512) { bh = u >> 4; const int qb = u & 15; qrow0 = qb * 256; orow0 = (bh >> 3) * SEQ + qb * 256; seq = LKV; }
        else { bh = u - 512; qrow0 = SEQ; orow0 = TX + (bh >> 3) * CL; seq = CL; }
        att::attn_dense_body<192, 1>(QC + ((size_t)bh * LKV + qrow0) * 192, KC + (size_t)bh * LKV * 192, VC + (size_t)bh * 128 * LKV, LKV,
                                     YC + (size_t)orow0 * 1024 + (bh & 7) * 128, seq, lds_g);
    }
#endif
}

__device__ __forceinline__ void ph_norm_route(const Params& P, int l, int Mq, LAS unsigned char* lds, bool dry = false) {
    unsigned char* const ws = lptr(P.ws);
    const int tid = ltid(), lane = tid & 63, wid = tid >> 6, G = gridDim.x;
    constexpr int HSP = D + 4;
    LAS float* hs = (LAS float*)lds; LAS float* part = (LAS float*)(lds + 66048); LAS int* lcnt = (LAS int*)(lds + 66048 + 16384); LAS int* lbase = lcnt + 32; LAS int* ent = lbase + 32;
    const float* modv = (const float*)(ws + WS_MODV) + (size_t)l * 5 * 12288; const bf16_t* X1 = (const bf16_t*)(ws + WS_X1); bf16_t* H = (bf16_t*)(ws + WS_H);
    int* rte = (int*)(ws + WS_RTE); int* rtp = (int*)(ws + WS_RTP); float* rtw = (float*)(ws + WS_RTW);
    unsigned* gcnt = (unsigned*)(ws + WS_CTL) + CW_CNT + l * 32;
    if (tid < 32) lcnt[tid] = 0;
    __syncthreads();
    int nent = 0;
    const int per = (Mq + G - 1) / G, rbase = blockIdx.x * per, rend = (rbase + per < Mq) ? rbase + per : Mq;
    ModVec mvec; int cur_rb = -1;
    const float lbias = (lane < 32) ? P.in[I_BROUTER][l * 32 + lane] : ((lane < 36) ? P.in[I_BGROUP][l * 4 + (lane - 32)] : 0.f);
    u32x2 raw[8];
    if (rbase + wid < rend) { const bf16_t* xr = X1 + (size_t)(rbase + wid) * D;
#pragma unroll
        for (int i = 0; i < 8; ++i) raw[i] = *(const u32x2*)(xr + i * 256 + lane * 4); }
    for (int r8 = rbase; r8 < rend; r8 += 8) {
        const int r = r8 + wid; const bool valid = r < rend;
        if (valid) { const int rb = row_rb(r);
          if (rb != cur_rb) { const float* m = modv + (size_t)rb * 12288; modvec_load(mvec, P.in[I_NORM2] + l * D, m + 8192, m + 6144, lane); cur_rb = rb; }
          f32x4 xv[8];
#pragma unroll
          for (int i = 0; i < 8; ++i) { const u32x2 w = raw[i]; xv[i] = (f32x4){BF_LO(w.x), BF_HI(w.x), BF_LO(w.y), BF_HI(w.y)}; }
          norm_mod_store2<true, false, true>(xv, mvec, H, (unsigned char*)(ws + WS_H8) + (size_t)r * D, hs + wid * HSP, lane); }
        __syncthreads();
        {
            const int kq = lane >> 4;
            f32x4 a3[3];
#pragma unroll
            for (int nt = 0; nt < 3; ++nt) a3[nt] = (f32x4){0.f, 0.f, 0.f, 0.f};
            const LAS float* hp = hs + (lane & 7) * HSP + wid * 256 + 8 * kq;
            const u32x4* wb = (const u32x4*)(ws + WS_WR) + (size_t)(l * 64 + wid * 8) * 3 * 2 * 64 + lane;
#pragma unroll 2
            for (int ks = 0; ks < 8; ++ks) {
                const f32x4 x0 = *(const LAS f32x4*)(hp + ks * 32), x1 = *(const LAS f32x4*)(hp + ks * 32 + 4);
                u32x4 bh[3], bl[3];
#pragma unroll
                for (int nt = 0; nt < 3; ++nt) { bh[nt] = wb[((ks * 3 + nt) * 2) * 64]; bl[nt] = wb[((ks * 3 + nt) * 2 + 1) * 64]; }
                u32x4 ah, al;
                ah.x = cvt_pk_bf16(x0[0], x0[1]); ah.y = cvt_pk_bf16(x0[2], x0[3]); ah.z = cvt_pk_bf16(x1[0], x1[1]); ah.w = cvt_pk_bf16(x1[2], x1[3]);
                al.x = cvt_pk_bf16(x0[0] - BF_LO(ah.x), x0[1] - BF_HI(ah.x)); al.y = cvt_pk_bf16(x0[2] - BF_LO(ah.y), x0[3] - BF_HI(ah.y));
                al.z = cvt_pk_bf16(x1[0] - BF_LO(ah.z), x1[1] - BF_HI(ah.z)); al.w = cvt_pk_bf16(x1[2] - BF_LO(ah.w), x1[3] - BF_HI(ah.w));
                const bf16x8 Ah = *reinterpret_cast<const bf16x8*>(&ah), Al = *reinterpret_cast<const bf16x8*>(&al);
#pragma unroll
                for (int nt = 0; nt < 3; ++nt) { const bf16x8 Bh = *reinterpret_cast<const bf16x8*>(&bh[nt]), Bl = *reinterpret_cast<const bf16x8*>(&bl[nt]);
                    a3[nt] = __builtin_amdgcn_mfma_f32_16x16x32_bf16(Al, Bh, a3[nt], 0, 0, 0);
                    a3[nt] = __builtin_amdgcn_mfma_f32_16x16x32_bf16(Ah, Bl, a3[nt], 0, 0, 0);
                    a3[nt] = __builtin_amdgcn_mfma_f32_16x16x32_bf16(Ah, Bh, a3[nt], 0, 0, 0); }
            }
            __builtin_amdgcn_sched_barrier(0);
            if (r + 8 < rend) { const bf16_t* xr = X1 + (size_t)(r + 8) * D;
#pragma unroll
                for (int i = 0; i < 8; ++i) raw[i] = *(const u32x2*)(xr + i * 256 + lane * 4); }
            __builtin_amdgcn_sched_barrier(0);
            if (kq < 2) {
#pragma unroll
                for (int nt = 0; nt < 3; ++nt)
#pragma unroll
                    for (int i = 0; i < 4; ++i) part[(wid * 8 + 4 * kq + i) * 64 + nt * 16 + (lane & 15)] = a3[nt][i]; }
        }
        __syncthreads();
        float lg = 0.f;
#pragma unroll
        for (int w = 0; w < 8; ++w) lg += part[(w * 8 + wid) * 64 + lane];
        lg += lbias;
        const float g0 = rdlane(lg, 32), g1 = rdlane(lg, 33), g2 = rdlane(lg, 34), g3 = rdlane(lg, 35);
        int gi = 0; float gb = g0; if (g1 > gb) { gb = g1; gi = 1; } if (g2 > gb) { gb = g2; gi = 2; } if (g3 > gb) { gb = g3; gi = 3; }
        const float gprob = 1.0f / (expf(g0 - gb) + expf(g1 - gb) + expf(g2 - gb) + expf(g3 - gb));
        float ev[8];
#pragma unroll
        for (int j = 0; j < 8; ++j) ev[j] = rdlane(lg, gi * 8 + j);
        int i0 = 0; float v0 = ev[0];
#pragma unroll
        for (int j = 1; j < 8; ++j) if (ev[j] > v0) { v0 = ev[j]; i0 = j; }
        int i1 = -1; float v1 = -3.0e38f;
#pragma unroll
        for (int j = 0; j < 8; ++j) if (j != i0 && ev[j] > v1) { v1 = ev[j]; i1 = j; }
        const float e1 = expf(v1 - v0), c0 = 1.0f / (1.0f + e1), c1 = e1 * c0;
        const int ex0 = gi * 8 + i0, ex1 = gi * 8 + i1;
        if (lane == 0 && !valid) { LAS int* en = ent + (nent + wid * 2) * 4; en[0] = -1; en[4] = -1; }
        if (lane == 0 && !dry && valid) {
            const int p0 = __hip_atomic_fetch_add(lcnt + ex0, 1, __ATOMIC_RELAXED, __HIP_MEMORY_SCOPE_WORKGROUP);
            const int p1 = __hip_atomic_fetch_add(lcnt + ex1, 1, __ATOMIC_RELAXED, __HIP_MEMORY_SCOPE_WORKGROUP);
            rte[r * 2] = ex0; rte[r * 2 + 1] = ex1; rtw[r * 2] = c0 * gprob; rtw[r * 2 + 1] = c1 * gprob;
            LAS int* en = ent + (nent + wid * 2) * 4; en[0] = r * 2; en[1] = ex0; en[2] = p0; en[4] = r * 2 + 1; en[5] = ex1; en[6] = p1;
        }
        nent += 16;
        __syncthreads();
    }
    if (dry) return;
    if (tid < 32) lbase[tid] = (int)__hip_atomic_fetch_add(gcnt + tid, (unsigned)lcnt[tid], __ATOMIC_RELAXED, __HIP_MEMORY_SCOPE_AGENT);
    __syncthreads();
    int* elist = (int*)(ws + WS_ELIST);
    for (int i = tid; i < nent; i += 512) { const LAS int* en = ent + i * 4; if (en[0] < 0) continue; const int pos = lbase[en[1]] + en[2]; rtp[en[0]] = pos; elist[(size_t)en[1] * MT + pos] = en[0] >> 1; }
    __syncthreads();
}

__device__ __forceinline__ void moe_tables(const Params& P, int l, LAS unsigned char* lds) {
    unsigned char* const ws = lptr(P.ws);
    const int tid = ltid();
    LAS int* nblk = (LAS int*)(lds + LDS_STAGE + MISC_NBLK); LAS int* blke = (LAS int*)(lds + LDS_STAGE + MISC_BLKE);
    LAS int* fblk = (LAS int*)(lds + LDS_STAGE + MISC_FBLK); LAS int* ecnt = (LAS int*)(lds + LDS_STAGE + MISC_ECNT);
    const unsigned* gcnt = (const unsigned*)(ws + WS_CTL) + CW_CNT + l * 32;
    LAS int* tmpb = (LAS int*)(lds + LDS_STAGE + MISC_TMPB);
    if (tid < NE) { const int c = (int)__hip_atomic_load(gcnt + tid, __ATOMIC_RELAXED, __HIP_MEMORY_SCOPE_AGENT); ecnt[tid] = c; tmpb[tid] = (c + 255) >> 8; }
    __syncthreads();
    if (tid < NE) {
        int pre = 0;
#pragma unroll 1
        for (int e = 0; e < tid; ++e) pre += tmpb[e];
        const int k = tmpb[tid];
        fblk[tid] = pre;
#pragma unroll 1
        for (int q = 0; q < k; ++q) if (pre + q < MAXBLK) blke[pre + q] = tid;
        if (tid == NE - 1) nblk[0] = (pre + k < MAXBLK) ? pre + k : MAXBLK; }
    __syncthreads();
}
__device__ __forceinline__ void ph_gather(const Params& P, int l, int Mq, LAS unsigned char* lds) {
    unsigned char* const ws = lptr(P.ws);
    const int tid = ltid(), lane = tid & 63, wid = tid >> 6, G = gridDim.x;
    LAS int* pstart = (LAS int*)lds;
    const unsigned* gcnt = (const unsigned*)(ws + WS_CTL) + CW_CNT + l * 32;
    if (tid == 0) { int acc = 0; for (int e = 0; e < NE; ++e) { pstart[e] = acc; const int c = (int)__hip_atomic_load(gcnt + e, __ATOMIC_RELAXED, __HIP_MEMORY_SCOPE_AGENT); acc += ((c + 255) >> 8) << 8; } }
    __syncthreads();
    const int* rte = (const int*)(ws + WS_RTE); const int* rtp = (const int*)(ws + WS_RTP); int* rts = (int*)(ws + WS_RTS);
    const bf16_t* H = (const bf16_t*)(ws + WS_H); bf16_t* XS = (bf16_t*)(ws + WS_XS);
    for (int a = blockIdx.x * 8 + wid; a < Mq * 2; a += G * 8) {
        const int r = a >> 1; int slot = pstart[rte[a]] + rtp[a]; if (slot >= MAXSLOT) slot = MAXSLOT - 1;
        if (lane == 0) rts[a] = slot;
        const u32x4* src = (const u32x4*)(H + (size_t)r * D); u32x4* dst = (u32x4*)(XS + (size_t)slot * D);
#pragma unroll
        for (int i = 0; i < 4; ++i) dst[i * 64 + lane] = src[i * 64 + lane];
    }
    __syncthreads();
}

__device__ __forceinline__ void ph_combine(const Params& P, int l, int Mq, LAS unsigned char* lds) {
    unsigned char* const ws = lptr(P.ws);
    const int tid = ltid(), lane = tid & 63, wid = tid >> 6, G = gridDim.x;
    moe_tables(P, l, lds);
    const LAS int* fblk = (const LAS int*)(lds + LDS_STAGE + MISC_FBLK); const int* rte = (const int*)(ws + WS_RTE); const int* rtp = (const int*)(ws + WS_RTP);
    const float* modv = (const float*)(ws + WS_MODV); const bf16_t* X1 = (const bf16_t*)(ws + WS_X1); bf16_t* X2 = (bf16_t*)(ws + WS_X2); bf16_t* H = (bf16_t*)(ws + WS_H);
    const float* rtw = (const float*)(ws + WS_RTW); const bf16_t* YS = (const bf16_t*)(ws + WS_YS);
    const bool last = (l == 1);
    const int per = (Mq + G - 1) / G, r0 = blockIdx.x * per, r1 = (r0 + per < Mq) ? r0 + per : Mq;
    ModVec mnext; f32x4 g2v[8]; int cur = -1;
    for (int r = r0 + wid; r < r1; r += 8) {
        const int rb = row_rb(r);
        if (rb != cur) { const float* g2 = modv + ((size_t)l * 5 + rb) * 12288 + 10240;
#pragma unroll
            for (int i = 0; i < 8; ++i) g2v[i] = *(const f32x4*)(g2 + i * 256 + lane * 4);
            if (!last) { const float* m = modv + ((size_t)(l + 1) * 5 + rb) * 12288; modvec_load(mnext, P.in[I_NORM1] + (l + 1) * D, m + 2048, m, lane); }
            cur = rb; }
        const int s0 = fblk[rte[r * 2]] * 256 + rtp[r * 2], s1 = fblk[rte[r * 2 + 1]] * 256 + rtp[r * 2 + 1]; const float w0 = rtw[r * 2], w1 = rtw[r * 2 + 1];
        const bf16_t* xr = X1 + (size_t)r * D; const bf16_t* y0 = YS + (size_t)s0 * D; const bf16_t* y1 = YS + (size_t)s1 * D;
        f32x4 xv[8];
#pragma unroll
        for (int i = 0; i < 8; ++i) { const int c = i * 256 + lane * 4; const u32x2 xw = *(const u32x2*)(xr + c); const f32x4 x = (f32x4){BF_LO(xw.x), BF_HI(xw.x), BF_LO(xw.y), BF_HI(xw.y)};
            const u32x2 a = *(const u32x2*)(y0 + c), bq = *(const u32x2*)(y1 + c);
            f32x4 m; m[0] = w0 * __uint_as_float(a.x << 16) + w1 * __uint_as_float(bq.x << 16); m[1] = w0 * __uint_as_float(a.x & 0xffff0000u) + w1 * __uint_as_float(bq.x & 0xffff0000u);
            m[2] = w0 * __uint_as_float(a.y << 16) + w1 * __uint_as_float(bq.y << 16); m[3] = w0 * __uint_as_float(a.y & 0xffff0000u) + w1 * __uint_as_float(bq.y & 0xffff0000u);
            xv[i] = x + g2v[i] * m; }
        if (last) {
#pragma unroll
            for (int i = 0; i < 8; ++i) *(f32x4*)(P.out + (size_t)r * D + i * 256 + lane * 4) = xv[i];
        } else {
#pragma unroll
            for (int i = 0; i < 8; ++i) { u32x2 w; w.x = cvt_pk_bf16(xv[i][0], xv[i][1]); w.y = cvt_pk_bf16(xv[i][2], xv[i][3]); *(u32x2*)(X2 + (size_t)r * D + i * 256 + lane * 4) = w; }
            norm_mod_store2<false, true, true>(xv, mnext, H + (size_t)r * D, (unsigned char*)(ws + WS_H8) + (size_t)r * D, (LAS float*)nullptr, lane);
        }
    }
}

constexpr int CVT_A1 = 0, CVT_A1_TOTAL = 200 * CVT_A1, CVT_A6 = 26;
constexpr int NPH = 27;
__global__ void __launch_bounds__(512, 2) mk_fwd(Params P) {
    extern __shared__ __attribute__((aligned(16))) unsigned char shm[];
    LAS unsigned char* lds = (LAS unsigned char*)shm;
    const int tid = ltid(), G = gridDim.x, bx = blockIdx.x;
    const int vcu = (G % 8 == 0) ? (bx % 8) * (G / 8) + bx / 8 : bx;
    for (int u = tid; u < LDS_MISC / 4; u += 512) ((LAS unsigned*)(lds + LDS_STAGE))[u] = 0u;
    __syncthreads();
    XcdBarrier bar; bar.bar = (unsigned*)(P.ws + WS_CTL) + CW_BAR; bar.x = 0; bar.st = nullptr;
#if !MK_PER_PHASE
    bar = xcd_barrier_post((unsigned*)(P.ws + WS_CTL) + CW_BAR, (volatile LAS unsigned*)(lds + LDS_STAGE));
#endif
    const int lo = P.ph_lo, hi = P.ph_hi;
#ifndef MK_MASK
#define MK_MASK 0xFFFFFFFFu
#endif
#define IN(k) (lo <= (k) && (k) < hi && ((MK_MASK >> ((k) == 0 ? 0 : 1 + ((k) - 1) % 13)) & 1u))
#ifndef MK_DUP
#define MK_DUP 0u
#endif
#define REPL(c) for (int rep_ = 0; rep_ < (IN(pb + (c)) ? 1 + (int)((MK_DUP >> (1 + (c))) & 1u) : 0); ++rep_) if ((rep_ == 0) || (xcd_barrier(bar), true))
#if MK_PER_PHASE
#define SEAM(k) do { } while (0)
#else
#define SEAM(k) do { if (IN(k) && IN((k) + 1)) xcd_barrier(bar); } while (0)
#endif
    for (int rep_ = 0; rep_ < (IN(0) ? 1 + (int)(MK_DUP & 1u) : 0); ++rep_) { if (rep_) xcd_barrier(bar); ph_prologue(P, lds); } SEAM(0);
#pragma unroll 1
    for (int l = 0; l < 2; ++l) {
        const int pb = 1 + 13 * l;
        const int Mq = (l == 0) ? MT : TX;
        REPL(0) { if (l == 0) ph_norm_in(P, MT); } SEAM(pb + 0);
        REPL(1) {
            { unsigned char* ws = lptr(P.ws); const unsigned char* wl = ws + WS_W + (size_t)l * WL_SIZE;
              pg8::Gemm g{(const bf16_t*)(ws + WS_H8), (const bf16_t*)(wl + WL_IN8), D, D, D};
              pg8::GridOrderDeal S; if (l == 0) S.init(MT / 256, INCP / 256 - (F8_HI - F8_LO), G, bx, 0, 1, F8_LO, F8_HI - F8_LO); else S.init(TX / 256, INCP / 256 - (F8_HI - F8_LO), G, bx, TC / 256, 4, F8_LO, F8_HI - F8_LO);
              { const int tot = S.nwg + S.extra; S.deal(tot / G, tot % G, 0);
                if (G == 256) { if (l == 0) S.deal(8, 140, 56); else S.deal(7, 192, 144); } }
              pg8::EpiP8 E{(bf16_t*)(ws + WS_P), INCP, 1.0f / (S8_H * S8_W)};
              pg8::gemm_phase8<pg8::EpiP8, pg8::GridOrderDeal>(lds, g, S, E); }
            { unsigned char* ws = lptr(P.ws); const unsigned char* wl = ws + WS_W + (size_t)l * WL_SIZE;
              pg8::Gemm g{(const bf16_t*)(ws + WS_H), (const bf16_t*)(wl + WL_IN), D, D, D};
              pg8::GridOrder S; S.init((l == 0 ? MT : TX) / 256, F8_HI - F8_LO, G, G - 1 - bx, 0, 1, 0, F8_LO);
              pg8::EpiBf16G E{(bf16_t*)(ws + WS_P), INCP, 1.0f};
              pg8::gemm_phase<pg8::EpiBf16G, pg8::GridOrder>(lds, g, S, E); }
            if (l == 0) { const int nun = (MT / 256) * (INCP / 256), n13 = nun - (nun / G) * G;
                if (n13 > 0 && bx >= n13) { const int nconv = G - n13; const int wend = P.tiles_l0 + nconv * CVT_A1; cvt_tiles(P, lds, P.tiles_l0 + (bx - n13), nconv, wend < P.total_tiles ? wend : P.total_tiles); } }
        } SEAM(pb + 1);
        REPL(2) { ph_post_in(P, l, Mq, lds); } SEAM(pb + 2);
        REPL(3) {
#pragma unroll 1
            for (int q = 0; q < 2; ++q) {
                unsigned char* ws = lptr(P.ws); const unsigned char* wl = ws + WS_W + (size_t)l * WL_SIZE;
                pg8::Gemm g{(const bf16_t*)(ws + (q ? WS_CQN : WS_CKVN)), (const bf16_t*)(wl + (q ? WL_UQ : WL_UKV)), q ? 512 : 256, q ? 512 : 256, q ? 512 : 256};
                pg8::GridOrder S; S.init((q ? Mq : MT) / 256, q ? 6 : 8, G, q ? G - 1 - bx : bx);
                pg8::EpiBf16 E{(bf16_t*)(ws + (q ? WS_QUP : WS_KVUP)), q ? 1536 : 2048, 1.0f / (S8_H * S8_WU)};
                pg8::gemm_phase8<pg8::EpiBf16, pg8::GridOrder>(lds, g, S, E);
            }
        } SEAM(pb + 3);
        REPL(4) { ph_post_up(P, l, Mq, lds); } SEAM(pb + 4);
        REPL(5) { ph_attention(P, l, (char*)shm, vcu); } SEAM(pb + 5);
        REPL(6) {
            {   const int br = 0;
                unsigned char* ws = lptr(P.ws); const unsigned char* wl = ws + WS_W + (size_t)l * WL_SIZE;
                pg8::Gemm g{(const bf16_t*)(ws + WS_YCAT + (size_t)br * MT * 1024 * 2), (const bf16_t*)(wl + WL_OA + (size_t)br * 2048 * 1024 * 2), 1024, 1024, 1024};
                pg8::GridOrder S; S.init(Mq / 256, 8, G, bx);
                pg8::EpiGateT<false> E{(bf16_t*)(ws + WS_M), (const unsigned char*)(ws + WS_P) + G8_OFF + br * D, INCP * 2, P.in[I_BGATE] + (size_t)l * 3 * D + br * D, 1.0f / (S8_Y * S8_W)};
                pg8::gemm_phase8<pg8::EpiGateT<false>, pg8::GridOrder>(lds, g, S, E);
            }
            {   const int br = 2;
                unsigned char* ws = lptr(P.ws); const unsigned char* wl = ws + WS_W + (size_t)l * WL_SIZE;
                pg8::Gemm g{(const bf16_t*)(ws + WS_YCAT + (size_t)br * MT * 1024 * 2), (const bf16_t*)(wl + WL_OA + (size_t)br * 2048 * 1024 * 2), 1024, 1024, 1024};
                pg8::GridOrder S; S.init(Mq / 256, 8, G, bx);
                pg8::EpiGateT<true> E{(bf16_t*)(ws + WS_M), (const unsigned char*)(ws + WS_P) + G8_OFF + br * D, INCP * 2, P.in[I_BGATE] + (size_t)l * 3 * D + br * D, 1.0f / (S8_Y * S8_W)};
                pg8::gemm_phase8<pg8::EpiGateT<true>, pg8::GridOrder>(lds, g, S, E);
            }
            {   unsigned char* ws = lptr(P.ws); const unsigned char* wl = ws + WS_W + (size_t)l * WL_SIZE;
                pg8::Gemm g{(const bf16_t*)(ws + WS_YCAT) + (size_t)MT * 1024, (const bf16_t*)(wl + WL_OB), 1024, 1024, 1024};
                pg8::GridOrder S; S.init(Mq / 256, 8, G, bx);
                pg8::EpiGateT<true> E{(bf16_t*)(ws + WS_M), (const unsigned char*)(ws + WS_P) + G8_OFF + D, INCP * 2, P.in[I_BGATE] + (size_t)l * 3 * D + D, 1.0f};
                pg8::gemm_phase<pg8::EpiGateT<true>, pg8::GridOrder>(lds, g, S, E);
            }
            if (l == 0) { const int n3 = (Mq / 256) * 8 - 2 * G;
                if (n3 > 0 && n3 < G && bx >= n3) { const int nconv = G - n3, w0 = P.tiles_l0 + CVT_A1_TOTAL, wsplit = w0 + nconv * CVT_A6; cvt_tiles(P, lds, w0 + (bx - n3), nconv, wsplit < P.total_tiles ? wsplit : P.total_tiles); } }
        } SEAM(pb + 6);
        REPL(7) {
            unsigned char* ws = lptr(P.ws); const unsigned char* wl = ws + WS_W + (size_t)l * WL_SIZE;
            const float* modv = (const float*)(ws + WS_MODV) + (size_t)l * 5 * 12288;
            pg8::Gemm g{(const bf16_t*)(ws + WS_M), (const bf16_t*)(wl + WL_O), D, D, D};
            pg8::GridOrder S; S.init(Mq / 256, 8, G, bx);
            pg8::EpiResid E{P.in[I_X], P.in[I_CTX] - (size_t)TX * D, (l == 0) ? (const bf16_t*)nullptr : (const bf16_t*)(ws + WS_X2), (bf16_t*)(ws + WS_X1), modv + 4096, 12288};
            pg8::gemm_phase<pg8::EpiResid, pg8::GridOrder>(lds, g, S, E);
            if (l == 0) { const int n3 = (Mq / 256) * 8 - 2 * G;
                if (n3 > 0 && n3 < G && bx >= n3) { const int nconv = G - n3, w0 = P.tiles_l0 + CVT_A1_TOTAL + nconv * CVT_A6; cvt_tiles(P, lds, w0 + (bx - n3), nconv, P.total_tiles); } }
        } SEAM(pb + 7);
        REPL(8) { ph_norm_route(P, l, Mq, lds, ((MK_DUP >> 9) & 1u) && rep_ == 0); } SEAM(pb + 8);
        REPL(10) {
            moe_tables(P, l, lds);
            unsigned char* ws = lptr(P.ws); const unsigned char* wl = ws + WS_W + (size_t)l * WL_SIZE;
            pg8::Gemm g{(const bf16_t*)(ws + WS_H8), (const bf16_t*)(wl + WL_GU), D, D, D};
            pg8::MoeOrder S{*(const LAS int*)(lds + LDS_STAGE + MISC_NBLK), 4, G, vcu, (const LAS int*)(lds + LDS_STAGE + MISC_BLKE),
                            (const LAS int*)(lds + LDS_STAGE + MISC_FBLK), (const LAS int*)(lds + LDS_STAGE + MISC_ECNT), (const int*)(ws + WS_ELIST)};
            pg8::EpiSwiglu8 E{(unsigned char*)(ws + WS_ACT), 1.0f / (S8_H * S8_W)};
            pg8::gemm_phase8<pg8::EpiSwiglu8, pg8::MoeOrder, true, true>(lds, g, S, E);
        } SEAM(pb + 10);
        REPL(11) {
            moe_tables(P, l, lds);
            unsigned char* ws = lptr(P.ws); const unsigned char* wl = ws + WS_W + (size_t)l * WL_SIZE;
            pg8::Gemm g{(const bf16_t*)(ws + WS_ACT), (const bf16_t*)(wl + WL_DN), DE, DE, DE};
            pg8::MoeOrder S{*(const LAS int*)(lds + LDS_STAGE + MISC_NBLK), 8, G, vcu, (const LAS int*)(lds + LDS_STAGE + MISC_BLKE), nullptr, nullptr, nullptr};
            pg8::EpiBf16Moe E{(bf16_t*)(ws + WS_YS), D, 8, 1.0f / (S8_ACT * S8_WD)};
            pg8::gemm_phase8<pg8::EpiBf16Moe, pg8::MoeOrder>(lds, g, S, E);
        } SEAM(pb + 11);
        REPL(12) { ph_combine(P, l, Mq, lds); } if (l == 0) SEAM(pb + 12);
#ifdef MK_XBAR
        if (l == 1) { for (int q = 0; q < MK_XBAR; ++q) xcd_barrier(bar); }
#endif
    }
#undef IN
#undef SEAM
}


#if MK_CHECK
constexpr size_t CW_CHK = 8192;
__device__ __forceinline__ unsigned hash32(unsigned x) { x ^= x >> 16; x *= 0x7feb352dU; x ^= x >> 15; x *= 0x846ca68bU; x ^= x >> 16; return x; }
__device__ __forceinline__ float dotbf(const bf16_t* a, const bf16_t* b, int K) { float s = 0.f; for (int k = 0; k < K; ++k) s += bf2f(a[k]) * bf2f(b[k]); return s; }
__device__ __forceinline__ void chk_report(unsigned* cnt, int id, float got, float ref, float scale) {
    const float err = fabsf(got - ref), tol = 0.03f * fabsf(ref) + 0.03f * scale;
    if (!(err <= tol)) atomicAdd(cnt + id, 1u);
}
__global__ void __launch_bounds__(256) chk_kernel(Params P, int l, int kind, int id) {
    unsigned char* ws = P.ws; unsigned* cnt = (unsigned*)(ws + WS_CTL) + CW_CHK;
    const unsigned char* wl = ws + WS_W + (size_t)l * WL_SIZE;
    const int Mq = (l == 0) ? MT : TX;
    const unsigned t = blockIdx.x * 256 + threadIdx.x; const unsigned h1 = hash32(t * 2 + 1), h2 = hash32(t * 2 + 2 + 0x9e3779b9u);
    if (kind == 0) { const int row = h1 % MT, col = h2 % ((l == 1 && row >= TX) ? 832 : INC);
        const float ref = dotbf((const bf16_t*)(ws + WS_H) + (size_t)row * D, (const bf16_t*)(wl + WL_IN) + (size_t)col * D, D);
        chk_report(cnt, id, bf2f(((const bf16_t*)(ws + WS_P))[(size_t)row * INCP + col]), ref, 1.f); }
    if (kind == 1) { const int row = h1 % MT, col = h2 % 2048;
        const float ref = dotbf((const bf16_t*)(ws + WS_CKVN) + (size_t)row * 256, (const bf16_t*)(wl + WL_UKV) + (size_t)col * 256, 256);
        chk_report(cnt, id, bf2f(((const bf16_t*)(ws + WS_KVUP))[(size_t)row * 2048 + col]), ref, 1.f); }
    if (kind == 2) { const int row = h1 % Mq, col = h2 % 1536;
        const float ref = dotbf((const bf16_t*)(ws + WS_CQN) + (size_t)row * 512, (const bf16_t*)(wl + WL_UQ) + (size_t)col * 512, 512);
        chk_report(cnt, id, bf2f(((const bf16_t*)(ws + WS_QUP))[(size_t)row * 1536 + col]), ref, 1.f); }
    if (kind == 3) { const int row = h1 % Mq, col = h2 % D; float m = 0.f;
        for (int br = 0; br < 3; ++br) { const float d = dotbf((const bf16_t*)(ws + WS_YCAT) + ((size_t)br * MT + row) * 1024, (const bf16_t*)(wl + WL_OA) + ((size_t)br * 2048 + col) * 1024, 1024);
            const float gl = bf2f(((const bf16_t*)(ws + WS_P))[(size_t)row * INCP + C_GL + br * D + col]) + P.in[I_BGATE][(size_t)l * 3 * D + br * D + col];
            m += d / (1.f + expf(-gl)); }
        chk_report(cnt, id, bf2f(((const bf16_t*)(ws + WS_M))[(size_t)row * D + col]), m, 1.f); }
    if (kind == 4) { const int row = h1 % Mq, col = h2 % D;
        const float d = dotbf((const bf16_t*)(ws + WS_M) + (size_t)row * D, (const bf16_t*)(wl + WL_O) + (size_t)col * D, D);
        const float xi = (l == 0) ? ((row < TX) ? P.in[I_X][(size_t)row * D + col] : P.in[I_CTX][(size_t)(row - TX) * D + col]) : ((const float*)(ws + WS_X2))[(size_t)row * D + col];
        const float g1 = ((const float*)(ws + WS_MODV))[((size_t)l * 5 + row_rb(row)) * 12288 + 4096 + col];
        chk_report(cnt, id, ((const float*)(ws + WS_X1))[(size_t)row * D + col], xi + g1 * d, 1.f); }
    if (kind == 5 || kind == 6) {
        const int a = h1 % (Mq * 2); const int e = ((const int*)(ws + WS_RTE))[a], slot = ((const int*)(ws + WS_RTS))[a], r = a >> 1;
        if (kind == 5) { const int col = h2 % DE;
            const bf16_t hx = ((const bf16_t*)(ws + WS_H))[(size_t)r * D + (h2 % D)], xx = ((const bf16_t*)(ws + WS_XS))[(size_t)slot * D + (h2 % D)];
            if (hx != xx) atomicAdd(cnt + id, 1u);
            const float* wg = P.in[I_WGU] + ((size_t)l * NE + e) * D * 1024; float g = 0.f, u = 0.f;
            for (int k = 0; k < D; ++k) { const float x = bf2f(((const bf16_t*)(ws + WS_XS))[(size_t)slot * D + k]); g += x * wg[(size_t)k * 1024 + col]; u += x * wg[(size_t)k * 1024 + DE + col]; }
            chk_report(cnt, id, bf2f(((const bf16_t*)(ws + WS_ACT))[(size_t)slot * DE + col]), g / (1.f + expf(-g)) * u, 1.f); }
        else { const int col = h2 % D; const float* wd = P.in[I_WDOWN] + ((size_t)l * NE + e) * DE * D; float y = 0.f;
            for (int k = 0; k < DE; ++k) y += bf2f(((const bf16_t*)(ws + WS_ACT))[(size_t)slot * DE + k]) * wd[(size_t)k * D + col];
            chk_report(cnt, id, bf2f(((const bf16_t*)(ws + WS_YS))[(size_t)slot * D + col]), y, 1.f); } }
    if (kind == 7) { const int row = h1 % Mq, c = h2 % 1024; const bf16_t* Pb = (const bf16_t*)(ws + WS_P);
        const bool isx = row < TX; const int s_ = isx ? (row & (SEQ - 1)) : ((row - TX) & (CL - 1)); const int slen = isx ? SEQ : CL;
        const float* cw = P.in[I_CONVW] + (size_t)l * 3 * 1024;
        auto z = [&](int rr) { return bf2f(Pb[(size_t)rr * INCP + C_XB + c]) * bf2f(Pb[(size_t)rr * INCP + C_GC + c]); };
        float acc = cw[1024 + c] * z(row); if (s_ > 0) acc += cw[c] * z(row - 1); if (s_ < slen - 1) acc += cw[2048 + c] * z(row + 1);
        chk_report(cnt, id, bf2f(((const bf16_t*)(ws + WS_YCAT))[((size_t)MT + row) * 1024 + c]), bf2f(Pb[(size_t)row * INCP + C_GB + c]) * acc, 1.f); }
    const float* modv_all = (const float*)(ws + WS_MODV);
    if (kind == 8) { const int r = h1 % 5, j = h2 % 12288; float acc = 0.f;
        for (int k = 0; k < D; ++k) { const float v = (r < 4) ? P.in[I_C][r * D + k] : P.in[I_CCTX][k]; acc += v / (1.f + expf(-v)) * P.in[I_WMOD][((size_t)l * D + k) * 12288 + j]; }
        chk_report(cnt, id, modv_all[((size_t)l * 5 + r) * 12288 + j], acc + P.in[I_BMOD][l * 12288 + j], 0.3f); }
    if (kind == 9) {
        const int row = h1 % MT, col = h2 % D; const float* xr = (l == 0) ? ((row < TX) ? P.in[I_X] + (size_t)row * D : P.in[I_CTX] + (size_t)(row - TX) * D) : (const float*)(ws + WS_X2) + (size_t)row * D;
        float ss = 0.f; for (int k = 0; k < D; ++k) ss += xr[k] * xr[k];
        const float* mv = modv_all + ((size_t)l * 5 + row_rb(row)) * 12288;
        const float ref = xr[col] / sqrtf(ss / D + EPS) * P.in[I_NORM1][l * D + col] * (1.f + mv[2048 + col]) + mv[col];
        chk_report(cnt, id, bf2f(((const bf16_t*)(ws + WS_H))[(size_t)row * D + col]), ref, 1.f); }
    if (kind == 10 || kind == 12) {
        const bool mla = (kind == 12); const int row = h1 % MT; const bool isx = row < TX; const int b = isx ? (row >> 12) : ((row - TX) >> 8), s_ = isx ? (row & (SEQ - 1)) : ((row - TX) & (CL - 1));
        const int key = isx ? CL + s_ : s_, qrow = isx ? s_ : SEQ + s_; const int HD_ = mla ? 192 : 128;
        const bool isq = ((h2 >> 20) & 1) && row < Mq; const int nh = (isq || mla) ? 8 : 2; const int hh = (h2 >> 8) % nh, d = (h2 & 255) % HD_;
        const bf16_t* Pb = (const bf16_t*)(ws + WS_P) + (size_t)row * INCP;
        auto getv = [&](int i) -> float {
            if (!mla) return bf2f(Pb[(isq ? C_Q : C_K) + hh * 128 + i]);
            if (isq) return bf2f(((const bf16_t*)(ws + WS_QUP))[(size_t)row * 1536 + hh * 192 + i]);
            return (i < 128) ? bf2f(((const bf16_t*)(ws + WS_KVUP))[(size_t)row * 2048 + hh * 256 + i]) : bf2f(Pb[C_KR + i - 128]); };
        float ss = 0.f; for (int i = 0; i < HD_; ++i) { const float x = getv(i); ss += x * x; }
        const float rs = 1.f / sqrtf(ss / HD_ + EPS);
        const float* gn = mla ? (isq ? P.in[I_MQN] : P.in[I_MKN]) + l * 192 : (isq ? P.in[I_GQN] : P.in[I_GKN]) + l * 128;
        float ref = getv(d) * rs * gn[d];
        const int r0 = mla ? 128 : 0, half = mla ? 32 : 64, nq = mla ? 16 : 32;
        if (isx && d >= r0) { const int i = (d - r0) % half; const bool second = (d - r0) >= half; const float pos = (i < nq) ? (float)(s_ >> 6) : (float)(s_ & 63);
            const float ang = pos * powf(10000.0f, -(float)(i % nq) / (float)nq); const float cs = cosf(ang), sn = sinf(ang);
            const float y1 = getv(r0 + i) * rs * gn[r0 + i], y2 = getv(r0 + half + i) * rs * gn[r0 + half + i]; ref = second ? (y2 * cs + y1 * sn) : (y1 * cs - y2 * sn); }
        float got;
        if (!mla) got = isq ? bf2f(((const bf16_t*)(ws + WS_QA))[((size_t)(b * 8 + hh) * LKV + qrow) * 128 + d]) : bf2f(((const bf16_t*)(ws + WS_KA))[((size_t)(b * 2 + hh) * LKV + key) * 128 + d]);
        else got = isq ? bf2f(((const bf16_t*)(ws + WS_QC))[((size_t)(b * 8 + hh) * LKV + qrow) * 192 + d]) : bf2f(((const bf16_t*)(ws + WS_KC))[((size_t)(b * 8 + hh) * LKV + key) * 192 + d]);
        chk_report(cnt, id, got, ref, 1.f);
        if (mla && !isq && d < 128) {
            const bf16_t a = ((const bf16_t*)(ws + WS_KVUP))[(size_t)row * 2048 + hh * 256 + 128 + d], c2 = ((const bf16_t*)(ws + WS_VC))[((size_t)(b * 8 + hh) * LKV + key) * 128 + d]; if (a != c2) atomicAdd(cnt + id, 1u); }
        if (!mla && !isq) { const bf16_t a = Pb[C_V + hh * 128 + d], c2 = ((const bf16_t*)(ws + WS_VA))[((size_t)(b * 2 + hh) * LKV + key) * 128 + d]; if (a != c2) atomicAdd(cnt + id, 1u); } }
    if (kind == 11) {
        const int row = h1 % Mq; const bool q = (h2 >> 20) & 1; const int n = q ? 512 : 256, c0 = q ? C_CQ : C_CKV, d = (h2 & 0xffff) % n; const bf16_t* Pb = (const bf16_t*)(ws + WS_P) + (size_t)row * INCP;
        float ss = 0.f; for (int i = 0; i < n; ++i) { const float x = bf2f(Pb[c0 + i]); ss += x * x; }
        const float ref = bf2f(Pb[c0 + d]) / sqrtf(ss / n + EPS) * (q ? P.in[I_MQLN][l * 512 + d] : P.in[I_MKVLN][l * 256 + d]);
        chk_report(cnt, id, q ? bf2f(((const bf16_t*)(ws + WS_CQN))[(size_t)row * 512 + d]) : bf2f(((const bf16_t*)(ws + WS_CKVN))[(size_t)row * 256 + d]), ref, 1.f); }
    if (kind == 13 || kind == 14) {
        const bool mla = (kind == 14); const int row = h1 % Mq; const bool isx = row < TX; const int b = isx ? (row >> 12) : ((row - TX) >> 8), s_ = isx ? (row & (SEQ - 1)) : ((row - TX) & (CL - 1));
        const int qrow = isx ? s_ : SEQ + s_, nk = isx ? LKV : CL, hh = (h2 >> 8) & 7, d = h2 & 127, HD_ = mla ? 192 : 128;
        const bf16_t* q = mla ? (const bf16_t*)(ws + WS_QC) + ((size_t)(b * 8 + hh) * LKV + qrow) * 192 : (const bf16_t*)(ws + WS_QA) + ((size_t)(b * 8 + hh) * LKV + qrow) * 128;
        const bf16_t* kb = mla ? (const bf16_t*)(ws + WS_KC) + (size_t)(b * 8 + hh) * LKV * 192 : (const bf16_t*)(ws + WS_KA) + (size_t)(b * 2 + (hh >> 2)) * LKV * 128;
        const bf16_t* vb = mla ? (const bf16_t*)(ws + WS_VC) + (size_t)(b * 8 + hh) * LKV * 128 : (const bf16_t*)(ws + WS_VA) + (size_t)(b * 2 + (hh >> 2)) * LKV * 128;
        const float sc = 1.0f / sqrtf((float)HD_); float mx = -1e30f, den = 0.f, num = 0.f;
        for (int k = 0; k < nk; ++k) { const float sv = dotbf(q, kb + (size_t)k * HD_, HD_) * sc; if (sv > mx) { const float f = expf(mx - sv); den *= f; num *= f; mx = sv; }
            const float p = expf(sv - mx); den += p; num += p * bf2f(vb[(size_t)k * 128 + d]); }
        const float got = bf2f(((const bf16_t*)(ws + WS_YCAT))[((size_t)(mla ? 2 : 0) * MT + row) * 1024 + hh * 128 + d]);
        chk_report(cnt, id, got, num / den, 0.05f); }
    if (kind == 15) {
        const int row = h1 % Mq; const float* xr = (const float*)(ws + WS_X1) + (size_t)row * D; const int col = h2 % D;
        float ss = 0.f; for (int k = 0; k < D; ++k) ss += xr[k] * xr[k];
        const float rs = 1.f / sqrtf(ss / D + EPS); const float* mv = modv_all + ((size_t)l * 5 + row_rb(row)) * 12288; const float* gn = P.in[I_NORM2] + l * D;
        chk_report(cnt, id, bf2f(((const bf16_t*)(ws + WS_H))[(size_t)row * D + col]), xr[col] * rs * gn[col] * (1.f + mv[8192 + col]) + mv[6144 + col], 1.f);
        float g4[4];
#pragma unroll
        for (int o = 0; o < 4; ++o) g4[o] = P.in[I_BGROUP][l * 4 + o];
        for (int k = 0; k < D; ++k) { const float hv = xr[k] * rs * gn[k] * (1.f + mv[8192 + k]) + mv[6144 + k];
#pragma unroll
            for (int o = 0; o < 4; ++o) g4[o] += hv * P.in[I_WGROUP][((size_t)l * D + k) * 4 + o]; }
        int gi = 0; float gb = g4[0];
#pragma unroll
        for (int o = 1; o < 4; ++o) if (g4[o] > gb) { gb = g4[o]; gi = o; }
        float den = 0.f;
#pragma unroll
        for (int o = 0; o < 4; ++o) den += expf(g4[o] - gb);
        float e8[8];
#pragma unroll
        for (int j = 0; j < 8; ++j) e8[j] = P.in[I_BROUTER][l * 32 + gi * 8 + j];
        for (int k = 0; k < D; ++k) { const float hv = xr[k] * rs * gn[k] * (1.f + mv[8192 + k]) + mv[6144 + k];
#pragma unroll
            for (int j = 0; j < 8; ++j) e8[j] += hv * P.in[I_WROUTER][((size_t)l * D + k) * NE + gi * 8 + j]; }
        int i0 = 0; float v0 = e8[0];
#pragma unroll
        for (int j = 1; j < 8; ++j) if (e8[j] > v0) { v0 = e8[j]; i0 = j; }
        int i1 = -1; float v1 = -3.0e38f;
#pragma unroll
        for (int j = 0; j < 8; ++j) if (j != i0 && e8[j] > v1) { v1 = e8[j]; i1 = j; }
        const float e1 = expf(v1 - v0); const float w0 = 1.f / (1.f + e1) / den, w1 = e1 / (1.f + e1) / den;
        const int* rte = (const int*)(ws + WS_RTE); const float* rtw = (const float*)(ws + WS_RTW);
        if (rte[row * 2] != gi * 8 + i0) atomicAdd(cnt + id + 4, 1u); else if (rte[row * 2 + 1] != gi * 8 + i1) atomicAdd(cnt + id + 5, 1u);
        else { chk_report(cnt, id + 6, rtw[row * 2], w0, 0.05f); chk_report(cnt, id + 6, rtw[row * 2 + 1], w1, 0.05f); } }
    if (kind == 16) {
        const int row = h1 % Mq, col = h2 % D; const int* rts = (const int*)(ws + WS_RTS); const float* rtw = (const float*)(ws + WS_RTW); const bf16_t* YS = (const bf16_t*)(ws + WS_YS);
        const float g2 = modv_all[((size_t)l * 5 + row_rb(row)) * 12288 + 10240 + col];
        const float ref = ((const float*)(ws + WS_X1))[(size_t)row * D + col] + g2 * (rtw[row * 2] * bf2f(YS[(size_t)rts[row * 2] * D + col]) + rtw[row * 2 + 1] * bf2f(YS[(size_t)rts[row * 2 + 1] * D + col]));
        const float got = (l == 1) ? P.out[(size_t)row * D + col] : ((const float*)(ws + WS_X2))[(size_t)row * D + col];
        chk_report(cnt, id, got, ref, 1.f); }
}
__global__ void chk_final(Params P) {
    const unsigned* cnt = (const unsigned*)(P.ws + WS_CTL) + CW_CHK; int bad = 0;
    for (int i = 1; i < 64; ++i) if (cnt[i] != 0u) { bad = i; break; }
    if (bad) { float v = 1024.f; for (int i = 0; i < bad; ++i) v *= 2.f; for (size_t i = (size_t)blockIdx.x * 256 + threadIdx.x; i < (size_t)TX * D; i += (size_t)gridDim.x * 256) P.out[i] = v; }
}
#endif

extern "C" void kernel_launch(void* const* d_in, const int* in_sizes, int n_in, void* d_out, int out_size, void* d_ws, size_t ws_size, hipStream_t stream) {
    static int grid = 0;
    if (grid == 0) {
        if (n_in != 29 || in_sizes[0] != TX * D || out_size != TX * D || ws_size < WS_END) {
            fprintf(stderr, "kernel_launch: shape mismatch: n_in %d in0 %d out %d ws %zu (need %zu)\n", n_in, n_in > 0 ? in_sizes[0] : -1, out_size, ws_size, (size_t)WS_END); grid = -1; return; }
        int dev = 0, cus = 0, per_cu = 0;
        if (hipGetDevice(&dev) != hipSuccess || hipDeviceGetAttribute(&cus, hipDeviceAttributeMultiprocessorCount, dev) != hipSuccess) { grid = -1; return; }
        if (hipFuncSetAttribute((const void*)mk_fwd, hipFuncAttributeMaxDynamicSharedMemorySize, LDS_BYTES) != hipSuccess) { fprintf(stderr, "kernel_launch: hipFuncSetAttribute failed\n"); grid = -1; return; }
        if (hipOccupancyMaxActiveBlocksPerMultiprocessor(&per_cu, (const void*)mk_fwd, 512, LDS_BYTES) != hipSuccess || per_cu < 1) {
            fprintf(stderr, "kernel_launch: occupancy query says %d blocks per CU\n", per_cu); (void)hipGetLastError(); grid = -1; return; }
        grid = cus;
    }
    if (grid < 0) return;
    (void)hipMemsetAsync((char*)d_ws + WS_CTL, 0, CTL_BYTES, stream);
    Params p{};
    for (int i = 0; i < 29; ++i) p.in[i] = (const float*)d_in[i];
    p.out = (float*)d_out; p.ws = (unsigned char*)d_ws;
    {
        int nj = 0, t0 = 0;
        auto add = [&](const float* src, size_t dst_off, int K, int N, int Npad, int batch, int mode, float scale = 1.f, int ld = 0) {
            CvtJob& j = p.jobs[nj++]; j.src = src; j.dst = (bf16_t*)((unsigned char*)d_ws + dst_off); j.K = K; j.N = N; j.Npad = Npad; j.batch = batch; j.mode = mode; j.tile0 = t0; j.scale = scale; j.ld = ld ? ld : N;
            t0 += batch * (K / 128) * (Npad / 128); };
        for (int l = 0; l < 2; ++l) {
            const size_t wl = WS_W + (size_t)l * WL_SIZE;
            add(p.in[I_WGU] + (size_t)l * NE * D * 1024, wl + WL_GU, D, 1024, 1024, NE, 3, S8_W);
            add(p.in[I_WDOWN] + (size_t)l * NE * DE * D, wl + WL_DN, DE, D, D, NE, 2, S8_WD);
            add(p.in[I_WIN] + (size_t)l * D * INC + F8_LO * 256, wl + WL_IN + (size_t)F8_LO * 256 * D * 2, D, (F8_HI - F8_LO) * 256, (F8_HI - F8_LO) * 256, 1, 0, 1.f, INC);
            add(p.in[I_WIN] + (size_t)l * D * INC, wl + WL_IN8, D, F8_LO * 256, F8_LO * 256, 1, 2, S8_W, INC);
            add(p.in[I_WIN] + (size_t)l * D * INC + F8_HI * 256, wl + WL_IN8 + (size_t)F8_HI * 256 * D, D, INC - F8_HI * 256, INCP - F8_HI * 256, 1, 2, S8_W, INC);
            add(p.in[I_WO] + (size_t)l * D * D, wl + WL_O, D, D, D, 1, 0);
            add(p.in[I_WOA] + (size_t)l * 1024 * D, wl + WL_OA, 1024, D, D, 1, 2, S8_W);
            add(p.in[I_WOB] + (size_t)l * 1024 * D, wl + WL_OB, 1024, D, D, 1, 0);
            add(p.in[I_WOC] + (size_t)l * 1024 * D, wl + WL_OC, 1024, D, D, 1, 2, S8_W);
            add(p.in[I_WUQ] + (size_t)l * 512 * 1536, wl + WL_UQ, 512, 1536, 1536, 1, 2, S8_WU);
            add(p.in[I_WUKV] + (size_t)l * 256 * 2048, wl + WL_UKV, 256, 2048, 2048, 1, 2, S8_WU);
        }
        p.total_tiles = t0; p.tiles_l0 = p.jobs[11].tile0;
    }
#if MK_PER_PHASE
    for (int k = 0; k < NPH; ++k) { if (k == 14) continue; p.ph_lo = k; p.ph_hi = k + 1; hipLaunchKernelGGL(mk_fwd, dim3(grid), dim3(512), LDS_BYTES, stream, p);
#if MK_CHECK
        { const int l = (k == 0) ? 0 : (k - 1) / 13, ph = (k == 0) ? -1 : (k - 1) % 13, base = 1 + 20 * l;
            auto C = [&](int ll, int kind, int id) { hipLaunchKernelGGL(chk_kernel, dim3(kind == 13 || kind == 14 || kind == 15 ? 16 : 128), dim3(256), 0, stream, p, ll, kind, id); };
            if (k == 0) { C(0, 8, 1); C(1, 8, 21); }
            if (ph == 0 && l == 0) C(0, 9, 2);
            if (ph == 1) C(l, 0, base + 2); if (ph == 2) { C(l, 7, base + 3); C(l, 10, base + 4); C(l, 11, base + 5); } if (ph == 3) { C(l, 1, base + 6); C(l, 2, base + 7); }
            if (ph == 4) C(l, 12, base + 8); if (ph == 5) { C(l, 13, base + 9); C(l, 14, base + 10); }
            if (ph == 6) C(l, 3, base + 11); if (ph == 7) C(l, 4, base + 12); if (ph == 8) C(l, 15, base + 13);
            if (ph == 10) C(l, 5, base + 14); if (ph == 11) C(l, 6, base + 15); if (ph == 12) { C(l, 16, base + 16); if (l == 0) C(1, 9, 22); } }
#endif
    }
#if MK_CHECK
    hipLaunchKernelGGL(chk_final, dim3(1024), dim3(256), 0, stream, p);
#endif
#else
    p.ph_lo = 0; p.ph_hi = NPH;
    hipLaunchKernelGGL(mk_fwd, dim3(grid), dim3(512), LDS_BYTES, stream, p);
#endif
    const hipError_t le = hipPeekAtLastError();
    if (le != hipSuccess) fprintf(stderr, "kernel_launch: launch failed: %s\n", hipGetErrorName(le));
}
```

```cpp
#include <hip/hip_runtime.h>
#include <hip/hip_bf16.h>
#include <cstdio>
#include <cstdint>

#ifndef MK_CHECK
#define MK_CHECK 0
#endif
#ifndef MK_PER_PHASE
#define MK_PER_PHASE 0
#endif

#define LAS __attribute__((address_space(3)))
typedef unsigned short bf16_t;
typedef short bf16x8 __attribute__((ext_vector_type(8)));
typedef short s16x4 __attribute__((ext_vector_type(4)));
typedef float f32x4 __attribute__((ext_vector_type(4)));
typedef float f32x2 __attribute__((ext_vector_type(2)));
typedef float f32x16 __attribute__((ext_vector_type(16)));
typedef unsigned u32x4 __attribute__((ext_vector_type(4)));
typedef unsigned u32x2 __attribute__((ext_vector_type(2)));

constexpr int D = 2048, NB = 4, SEQ = 4096, CL = 256, LKV = SEQ + CL;
constexpr int TX = NB * SEQ, TC = NB * CL, MT = TX + TC;
constexpr int INC = 11584, INCP = 11776;
constexpr int C_K = 0, C_V = 256, C_CKV = 512, C_KR = 768, C_Q = 832, C_CQ = 1856, C_XB = 2368, C_GB = 3392, C_GC = 4416, C_GL = 5440;
constexpr int G8_T0 = 22, G8_OFF = G8_T0 * 256 * 2;
constexpr int NE = 32, DE = 512;
constexpr float EPS = 1e-6f;
constexpr int MAXBLK = 168, MAXSLOT = MAXBLK * 256;

__device__ __forceinline__ float bf2f(bf16_t b) { return __uint_as_float(((unsigned)b) << 16); }
#define BF_LO(w) __uint_as_float((w) << 16)
#define BF_HI(w) __uint_as_float((w) & 0xffff0000u)
__device__ __forceinline__ unsigned cvt_pk_bf16(float lo, float hi) { unsigned r; asm volatile("v_cvt_pk_bf16_f32 %0, %1, %2" : "=v"(r) : "v"(lo), "v"(hi)); return r; }
__device__ __forceinline__ bf16_t f2bf(float x) { return (bf16_t)(cvt_pk_bf16(x, 0.f) & 0xffffu); }
__device__ __forceinline__ float clamp8(float x) { return fminf(fmaxf(x, -448.f), 448.f); }
__device__ __forceinline__ int pk4_fp8(float a, float b, float c, float d) { int w = __builtin_amdgcn_cvt_pk_fp8_f32(clamp8(a), clamp8(b), 0, false); return __builtin_amdgcn_cvt_pk_fp8_f32(clamp8(c), clamp8(d), w, true); }
constexpr float S8_WU = 256.f;
constexpr float S8_QK = 16.f;
constexpr float S8_P = 16.f, S8_V = 16.f, S8_Y = 16.f;
constexpr float S8_H = 16.f, S8_W = 1024.f, S8_ACT = 8.f, S8_WD = 512.f, S8_G = 16.f;
__device__ __forceinline__ float wave_sum(float v) {
    v += __int_as_float(__builtin_amdgcn_ds_swizzle(__float_as_int(v), 0x041F));
    v += __int_as_float(__builtin_amdgcn_ds_swizzle(__float_as_int(v), 0x081F));
    v += __int_as_float(__builtin_amdgcn_ds_swizzle(__float_as_int(v), 0x101F));
    v += __int_as_float(__builtin_amdgcn_ds_swizzle(__float_as_int(v), 0x201F));
    v += __int_as_float(__builtin_amdgcn_ds_swizzle(__float_as_int(v), 0x401F));
    auto rr = __builtin_amdgcn_permlane32_swap(__float_as_uint(v), __float_as_uint(v), false, false);
    return __uint_as_float(rr[0]) + __uint_as_float(rr[1]);
}
__device__ __forceinline__ float rdlane(float v, int l) { return __int_as_float(__builtin_amdgcn_readlane(__float_as_int(v), l)); }
__device__ __forceinline__ int uni(int v) { return __builtin_amdgcn_readfirstlane(v); }
template <class T> __device__ __forceinline__ T* uniptr(T* p) { const unsigned long long v = (unsigned long long)p; const unsigned lo = (unsigned)__builtin_amdgcn_readfirstlane((int)(unsigned)v), hi = (unsigned)__builtin_amdgcn_readfirstlane((int)(unsigned)(v >> 32)); return (T*)(((unsigned long long)hi << 32) | lo); }
template <class T> __device__ __forceinline__ T* lptr(T* p) { long z = 0; asm volatile("" : "+s"(z)); return (T*)((unsigned char*)p + z); }
__device__ __forceinline__ int ltid() { int t = threadIdx.x; asm volatile("" : "+v"(t)); return t; }
__device__ __forceinline__ float sigmoidf_(float x) { return 1.0f / (1.0f + __expf(-x)); }
__device__ __forceinline__ float sigmoidr_(float x) { return __builtin_amdgcn_rcpf(1.0f + __expf(-x)); }

#define XB_TMO      128
#define XB_XCNT(j)  (256  + 64 * (j))
#define XB_XSUB(j)  (1280 + 64 * (j))
#define XB_XGEN(j)  (2304 + 64 * (j))
#define XB_TOP      3328
#define XB_TOPGEN   3392
#define XCD_BAR_WORDS 3456
#define XB_SPIN_CAP (1u << 18)

__device__ __forceinline__ unsigned xb_ld(unsigned* p)              { return __hip_atomic_load(p, __ATOMIC_RELAXED, __HIP_MEMORY_SCOPE_AGENT); }
__device__ __forceinline__ unsigned xb_add(unsigned* p, unsigned v) { return __hip_atomic_fetch_add(p, v, __ATOMIC_RELAXED, __HIP_MEMORY_SCOPE_AGENT); }
__device__ __forceinline__ unsigned xb_xcc_id() { return (unsigned)__builtin_amdgcn_s_getreg((3 << 11) | 20) & 0xFu; }
#define XB_SPIN(cond, bar) do { unsigned _sp = 0; while (cond) { __builtin_amdgcn_s_sleep(1); \
    if ((++_sp & 255u) == 0u) { if (xb_ld(&(bar)[XB_TMO])) break; if (_sp > XB_SPIN_CAP) { atomicAdd(&(bar)[XB_TMO], 1u); break; } } } } while (0)

struct XcdBarrier { unsigned* bar; unsigned x; volatile LAS unsigned* st; };

__device__ __forceinline__ XcdBarrier xcd_barrier_post(unsigned* bar, volatile LAS unsigned* st) {
    XcdBarrier b; b.bar = bar; b.x = xb_xcc_id(); b.st = st;
    if (threadIdx.x == 0) (void)xb_add(&bar[XB_XCNT(b.x)], 1u);
    return b;
}
__device__ __forceinline__ void xcd_barrier_complete(unsigned* bar, unsigned x, unsigned& nloc, unsigned& nx) {
    const unsigned G = gridDim.x * gridDim.y * gridDim.z;
    unsigned sum, cnt, mine, sp = 0u;
    for (;;) {
        sum = 0u; cnt = 0u; mine = 0u;
#pragma unroll
        for (unsigned j = 0; j < 16; ++j) { const unsigned c = xb_ld(&bar[XB_XCNT(j)]); sum += c; cnt += (c > 0u) ? 1u : 0u; mine = (j == x) ? c : mine; }
        if (sum == G) break;
        __builtin_amdgcn_s_sleep(1);
        if ((++sp & 255u) == 0u) { if (xb_ld(&bar[XB_TMO])) break; if (sp > XB_SPIN_CAP) { atomicAdd(&bar[XB_TMO], 1u); break; } }
    }
    nloc = mine > 0u ? mine : 1u; nx = cnt > 0u ? cnt : 1u;
}
__device__ __forceinline__ void xcd_barrier(const XcdBarrier& b) {
    asm volatile("s_waitcnt vmcnt(0)" ::: "memory");
    __syncthreads();
    if (threadIdx.x == 0) {
        unsigned* bar = b.bar;
        __builtin_amdgcn_s_waitcnt(0);
        unsigned nloc = b.st[0], nx = b.st[1];
        if (nloc == 0u) { xcd_barrier_complete(bar, b.x, nloc, nx); b.st[0] = nloc; b.st[1] = nx; }
        const unsigned old = xb_add(&bar[XB_XSUB(b.x)], 1u);
        const unsigned gen = old / nloc;
        if (old + 1u == (gen + 1u) * nloc) {
            __builtin_amdgcn_fence(__ATOMIC_RELEASE, "agent");
            asm volatile("s_waitcnt vmcnt(0)" ::: "memory");
            const unsigned og = xb_add(&bar[XB_TOP], 1u);
            const unsigned tg = og / nx;
            if (og + 1u == (tg + 1u) * nx) xb_add(&bar[XB_TOPGEN], 1u);
            else XB_SPIN(xb_ld(&bar[XB_TOPGEN]) == tg, bar);
            __builtin_amdgcn_fence(__ATOMIC_ACQUIRE, "agent");
            xb_add(&bar[XB_XGEN(b.x)], 1u);
            asm volatile("s_waitcnt vmcnt(0)" ::: "memory");
        } else {
            XB_SPIN(xb_ld(&bar[XB_XGEN(b.x)]) == gen, bar);
            __builtin_amdgcn_fence(__ATOMIC_ACQUIRE, "agent");
            asm volatile("s_waitcnt vmcnt(0)" ::: "memory");
        }
    }
    __syncthreads();
}

namespace pg8 {
constexpr int BM = 256, BK = 64, HALF = 128, HTB = HALF * BK * 2, STAGE_BYTES = 8 * HTB, NXCD = 8, WGM = 8;
__host__ __device__ __forceinline__ int lds_byte(int r, int c) { const int st = (r >> 4) * 2 + (c >> 5), rr = r & 15, cc = c & 31, ob = rr * 64 + cc * 2; return st * 1024 + (ob ^ (((ob >> 9) & 1) << 5)); }
__host__ __device__ __forceinline__ void stage_rc(int b, int& R, int& C) { const int st = b / 1024, sb = b % 1024, swz = sb ^ (((sb >> 9) & 1) << 5); R = (st >> 1) * 16 + swz / 64; C = (st & 1) * 32 + (swz % 64) / 2; }
__host__ __device__ __forceinline__ int perm32(int rho) { const int n = rho >> 4, i = rho & 15; return 8 * (i >> 2) + 4 * n + (i & 3); }

struct Unit { int pm, pn; };
struct Gemm { const bf16_t* A; const bf16_t* Bt; int K, lda, ldb; };

struct GridOrder {
    int nM, nN, nwg, G, c, extra, extraN, cut, skip;
    __device__ void init(int nM_, int nN_, int G_, int c_, int extraM = 0, int extraN_ = 1, int cut_ = 0, int skip_ = 0) { nM = nM_; nN = nN_; nwg = nM * nN; G = G_; c = c_; extraN = extraN_; extra = extraM * extraN_; cut = cut_; skip = skip_; }
    __device__ bool next(int i, Unit& u) const {
        const long L = (long)i * G + c; if (L >= nwg + extra) return false;
        if (L >= nwg) { const int e = (int)L - nwg; u.pm = nM + e / extraN; u.pn = e % extraN; return true; }
        int wgid = (int)L; { const int q = nwg / NXCD, r = nwg % NXCD, xcd = wgid % NXCD, off = wgid / NXCD; wgid = (xcd < r ? xcd * (q + 1) : r * (q + 1) + (xcd - r) * q) + off; }
        const int nig = WGM * nN, gid = wgid / nig, fm = gid * WGM, gsz = (nM - fm) < WGM ? (nM - fm) : WGM;
        u.pm = fm + ((wgid % nig) % gsz); const int pj = (wgid % nig) / gsz; u.pn = (pj < cut) ? pj : pj + skip; return true;
    }
};
struct GridOrderDeal : GridOrder {
    int dl;
    __device__ void deal(int full_, int n1_, int n2_) { dl = full_ | (n1_ << 8) | (n2_ << 20); }
    __device__ bool next(int i, Unit& u) const {
        const int full = dl & 255, n1 = (dl >> 8) & 4095, n2 = dl >> 20;
        if (i < full) return GridOrder::next(i, u);
        if (i == full) { if (c >= n1) return false; return GridOrder::next(i, u); }
        if (i == full + 1) { if (c >= n2) return false; GridOrder t = *this; t.c = c + n1 - G; return t.next(i, u); }
        return false;
    }
};
struct MoeOrder {
    int nblk, nper, G, c; const LAS int* blk_e; const LAS int* fblk; const LAS int* ecnt; const int* elist;
    __device__ bool next(int i, Unit& u) const {
        const long L = (long)i * G + c; if (L >= (long)nblk * nper) return false;
        const int blk = (int)L / nper, pl = (int)L % nper; u.pm = blk; u.pn = blk_e[blk] * nper + pl; return true;
    }
    __device__ __forceinline__ int src_row(const Unit& u, int rit) const {
        const int e = u.pn / nper, idx = (u.pm - fblk[e]) * 256 + rit;
        return (idx < ecnt[e]) ? elist[(size_t)e * MT + idx] : 0;
    }
};
struct NoGather { };

typedef f32x4 Acc[2][2][4][2];

template <class Epi, class Sched, bool ALIGN_EPI = true, bool GATHER = false>
__device__ __forceinline__ void gemm_phase(LAS unsigned char* lds, const Gemm g, const Sched& S, const Epi& E) {
    const int tid = ltid(), wid = __builtin_amdgcn_readfirstlane(tid >> 6), lane = tid & 63, wr = wid >> 2, wc = wid & 3, fr = lane & 15, fq = lane >> 4;
    const int K = g.K, nt = K / BK;
    unsigned voffA[2], voffB[2];
#pragma unroll
    for (int i = 0; i < 2; ++i) { int R, C; stage_rc(tid * 16 + i * 8192, R, C); const int Rb = Epi::PERM ? ((R & ~31) + perm32(R & 31)) : R;
        voffA[i] = (unsigned)(R * g.lda + C) * 2u; voffB[i] = (unsigned)(Rb * g.ldb + C) * 2u; }
    unsigned vA0[2], vA1[2];
#define PG8_GROWS(u_, d0, d1) do { _Pragma("unroll") for (int i_ = 0; i_ < 2; ++i_) { int R_, C_; stage_rc(tid * 16 + i_ * 8192, R_, C_); d0[i_] = (unsigned)(S.src_row(u_, R_) * g.lda + C_) * 2u; d1[i_] = (unsigned)(S.src_row(u_, HALF + R_) * g.lda + C_) * 2u; } } while (0)
    const size_t kstep = (size_t)(BK * 2);
    const size_t hstepA = (size_t)HALF * g.lda * 2, hstepB = (size_t)HALF * g.ldb * 2;
    const size_t tstepA = 2 * hstepA, tstepB = 2 * hstepB;
    const unsigned ldsw = (unsigned)wid * 1024u;
    const int aoff = lds_byte(wr * 64 + fr, fq * 8), boff = lds_byte(wc * 32 + fr, fq * 8);
#define PG8_SA(b, h) (((b) * 2 + (h)) * HTB)
#define PG8_SB(b, h) ((4 + (b) * 2 + (h)) * HTB)
#define PG8_STAGE(bufoff, gbase, voff) do { _Pragma("unroll") for (int _i = 0; _i < 2; ++_i) \
        __builtin_amdgcn_global_load_lds((const unsigned*)((const char*)(gbase) + (voff)[_i]), (LAS unsigned*)(lds + (bufoff) + ldsw + _i * 8192), 16, 0, 0); } while (0)
#define PG8_LDA(dst, b, h) do { _Pragma("unroll") for (int m = 0; m < 4; ++m) _Pragma("unroll") for (int k = 0; k < 2; ++k) dst[m][k] = *(const LAS bf16x8*)(lds + PG8_SA(b, h) + aoff + m * 2048 + k * 1024); } while (0)
#define PG8_LDB(dst, b, h) do { _Pragma("unroll") for (int n = 0; n < 2; ++n) _Pragma("unroll") for (int k = 0; k < 2; ++k) dst[n][k] = *(const LAS bf16x8*)(lds + PG8_SB(b, h) + boff + n * 2048 + k * 1024); } while (0)
#define PG8_MMA(ai, bj, At, Bt) do { __builtin_amdgcn_s_setprio(1); _Pragma("unroll") for (int m = 0; m < 4; ++m) _Pragma("unroll") for (int n = 0; n < 2; ++n) _Pragma("unroll") for (int k = 0; k < 2; ++k) \
        acc[ai][bj][m][n] = __builtin_amdgcn_mfma_f32_16x16x32_bf16(Bt[n][k], At[m][k], acc[ai][bj][m][n], 0, 0, 0); __builtin_amdgcn_s_setprio(0); } while (0)
#define PG8_WAIT_V(n) asm volatile("s_waitcnt vmcnt(" #n ")" ::: "memory")
#define PG8_WAIT_L(n) asm volatile("s_waitcnt lgkmcnt(" #n ")" ::: "memory")
#define PG8_BAR __builtin_amdgcn_s_barrier()
#define PG8_SCHED __builtin_amdgcn_sched_barrier(0)
    Unit cur, nxt; int ui = 0;
    if (!S.next(0, cur)) return;
    Acc acc;
#pragma unroll
    for (int a = 0; a < 2; ++a)
#pragma unroll
        for (int b = 0; b < 2; ++b)
#pragma unroll
            for (int m = 0; m < 4; ++m)
#pragma unroll
                for (int n = 0; n < 2; ++n) acc[a][b][m][n] = (f32x4){0.f, 0.f, 0.f, 0.f};
    bf16x8 At[4][2], B0[2][2], B1[2][2];
    const char* cA = GATHER ? (const char*)g.A : (const char*)g.A + (size_t)cur.pm * tstepA; const char* cB = (const char*)g.Bt + (size_t)cur.pn * tstepB;
    if constexpr (GATHER) { PG8_GROWS(cur, vA0, vA1); }
    PG8_STAGE(PG8_SB(0, 0), cB, voffB); PG8_STAGE(PG8_SB(0, 1), cB + hstepB, voffB);
    if constexpr (GATHER) { PG8_STAGE(PG8_SA(0, 0), cA, vA0); PG8_STAGE(PG8_SA(0, 1), cA, vA1); } else { PG8_STAGE(PG8_SA(0, 0), cA, voffA); PG8_STAGE(PG8_SA(0, 1), cA + hstepA, voffA); }
    if (wr == 1) PG8_BAR;
    PG8_WAIT_V(2); PG8_BAR;
    PG8_STAGE(PG8_SB(1, 0), cB + kstep, voffB); if constexpr (GATHER) PG8_STAGE(PG8_SA(1, 0), cA + kstep, vA0); else PG8_STAGE(PG8_SA(1, 0), cA + kstep, voffA); PG8_STAGE(PG8_SB(1, 1), cB + hstepB + kstep, voffB);
    PG8_WAIT_V(6); PG8_BAR;
    for (;;) {
        const bool has_next = S.next(ui + 1, nxt);
        const char* nA = GATHER ? cA : (has_next ? (const char*)g.A + (size_t)nxt.pm * tstepA : cA); const char* nB = has_next ? (const char*)g.Bt + (size_t)nxt.pn * tstepB : cB;
        for (int t = 0; t < nt; t += 2) {
            const bool last = (t == nt - 2);
            const char* a1 = cA + (size_t)(t + 1) * kstep;
            const char* a2 = last ? nA : cA + (size_t)(t + 2) * kstep; const char* b2 = last ? nB : cB + (size_t)(t + 2) * kstep;
            const char* a3 = a2 + kstep; const char* b3 = b2 + kstep;
            PG8_LDB(B0, 0, 0); PG8_LDB(B1, 0, 1); PG8_SCHED; PG8_LDA(At, 0, 0); if constexpr (GATHER) PG8_STAGE(PG8_SA(1, 1), a1, vA1); else PG8_STAGE(PG8_SA(1, 1), a1 + hstepA, voffA);
            if constexpr (GATHER) { if (last && has_next) PG8_GROWS(nxt, vA0, vA1); }
            PG8_WAIT_V(8); PG8_WAIT_L(0); PG8_BAR; PG8_MMA(0, 0, At, B0); PG8_MMA(0, 1, At, B1); PG8_BAR; PG8_SCHED;
            PG8_LDA(At, 0, 1); PG8_STAGE(PG8_SB(0, 0), b2, voffB); PG8_STAGE(PG8_SB(0, 1), b2 + hstepB, voffB); if constexpr (GATHER) PG8_STAGE(PG8_SA(0, 0), a2, vA0); else PG8_STAGE(PG8_SA(0, 0), a2, voffA);
            PG8_WAIT_V(8); PG8_WAIT_L(0); PG8_BAR; PG8_MMA(1, 0, At, B0); PG8_MMA(1, 1, At, B1); PG8_BAR; PG8_SCHED;
            PG8_LDB(B0, 1, 0); PG8_LDB(B1, 1, 1); PG8_SCHED; PG8_LDA(At, 1, 0); if constexpr (GATHER) PG8_STAGE(PG8_SA(0, 1), a2, vA1); else PG8_STAGE(PG8_SA(0, 1), a2 + hstepA, voffA);
            PG8_WAIT_V(8); PG8_WAIT_L(0); PG8_BAR; PG8_MMA(0, 0, At, B0); PG8_MMA(0, 1, At, B1); PG8_BAR; PG8_SCHED;
            PG8_LDA(At, 1, 1); PG8_STAGE(PG8_SB(1, 0), b3, voffB); PG8_STAGE(PG8_SB(1, 1), b3 + hstepB, voffB); if constexpr (GATHER) PG8_STAGE(PG8_SA(1, 0), a3, vA0); else PG8_STAGE(PG8_SA(1, 0), a3, voffA);
            PG8_WAIT_V(8); PG8_WAIT_L(0); PG8_BAR; PG8_MMA(1, 0, At, B0); PG8_MMA(1, 1, At, B1); PG8_BAR; PG8_SCHED;
        }
        if constexpr (ALIGN_EPI) { if (wr == 0) PG8_BAR; }
        E(acc, cur, wr, wc, fr, fq);
        if (!has_next) break;
#pragma unroll
        for (int a = 0; a < 2; ++a)
#pragma unroll
            for (int b = 0; b < 2; ++b)
#pragma unroll
                for (int m = 0; m < 4; ++m)
#pragma unroll
                    for (int n = 0; n < 2; ++n) acc[a][b][m][n] = (f32x4){0.f, 0.f, 0.f, 0.f};
        cur = nxt; cA = nA; cB = nB; ++ui;
        if constexpr (ALIGN_EPI) { if (wr == 1) PG8_BAR; }
    }
    PG8_WAIT_V(0);
    if constexpr (!ALIGN_EPI) { if (wr == 0) PG8_BAR; }
    PG8_BAR;
#undef PG8_GROWS
#undef PG8_SA
#undef PG8_SB
#undef PG8_STAGE
#undef PG8_LDA
#undef PG8_LDB
#undef PG8_MMA
#undef PG8_WAIT_V
#undef PG8_WAIT_L
#undef PG8_BAR
#undef PG8_SCHED
}

typedef int v8i __attribute__((ext_vector_type(8)));
typedef int v4i __attribute__((ext_vector_type(4)));
template <class Epi, class Sched, bool ALIGN_EPI = true, bool GATHER = false>
__device__ __forceinline__ void gemm_phase8(LAS unsigned char* lds, const Gemm g, const Sched& S, const Epi& E) {
    const int tid = ltid(), wid = __builtin_amdgcn_readfirstlane(tid >> 6), lane = tid & 63, wr = wid >> 2, wc = wid & 3, fr = lane & 15, fq = lane >> 4;
    const int K = g.K, nt = K / 128;
    unsigned voffA[2], voffB[2];
#pragma unroll
    for (int i = 0; i < 2; ++i) { const int q = tid + 512 * i, R = q >> 3, kp = (q & 7) ^ ((R >> 1) & 7); const int Rb = Epi::PERM ? ((R & ~31) + perm32(R & 31)) : R;
        voffA[i] = (unsigned)(R * g.lda + kp * 16); voffB[i] = (unsigned)(Rb * g.ldb + kp * 16); }
    unsigned vA0[2], vA1[2];
#define PG8_GROWS(u_, d0, d1) do { _Pragma("unroll") for (int i_ = 0; i_ < 2; ++i_) { const int q_ = tid + 512 * i_, R_ = q_ >> 3, kp_ = (q_ & 7) ^ ((R_ >> 1) & 7); d0[i_] = (unsigned)(S.src_row(u_, R_) * g.lda + kp_ * 16); d1[i_] = (unsigned)(S.src_row(u_, HALF + R_) * g.lda + kp_ * 16); } } while (0)
    const size_t kstep = 128;
    const size_t hstepA = (size_t)HALF * g.lda, hstepB = (size_t)HALF * g.ldb;
    const size_t tstepA = 2 * hstepA, tstepB = 2 * hstepB;
    const unsigned ldsw = (unsigned)wid * 1024u;
    const int sw = (fr >> 1) & 7;
    const int aoff0 = (wr * 64 + fr) * 128 + (((2 * fq) ^ sw) << 4), boff0 = (wc * 32 + fr) * 128 + (((2 * fq) ^ sw) << 4);
#define PG8_SA(b, h) (((b) * 2 + (h)) * HTB)
#define PG8_SB(b, h) ((4 + (b) * 2 + (h)) * HTB)
#define PG8_STAGE(bufoff, gbase, voff) do { _Pragma("unroll") for (int _i = 0; _i < 2; ++_i) \
        __builtin_amdgcn_global_load_lds((const unsigned*)((const char*)(gbase) + (voff)[_i]), (LAS unsigned*)(lds + (bufoff) + ldsw + _i * 8192), 16, 0, 0); } while (0)
#define PG8_FR(dst, off0, off1) do { const v4i lo_ = *(const LAS v4i*)(lds + (off0)), hi_ = *(const LAS v4i*)(lds + (off1)); \
        dst = __builtin_shufflevector(lo_, hi_, 0, 1, 2, 3, 4, 5, 6, 7); } while (0)
#define PG8_LDA(dst, b, h) do { _Pragma("unroll") for (int m = 0; m < 4; ++m) PG8_FR(dst[m], PG8_SA(b, h) + aoff0 + m * 2048, PG8_SA(b, h) + (aoff0 ^ 16) + m * 2048); } while (0)
#define PG8_LDB(dst, b, h) do { _Pragma("unroll") for (int n = 0; n < 2; ++n) PG8_FR(dst[n], PG8_SB(b, h) + boff0 + n * 2048, PG8_SB(b, h) + (boff0 ^ 16) + n * 2048); } while (0)
#define PG8_MMA(ai, bj, At, Bt) do { __builtin_amdgcn_s_setprio(1); _Pragma("unroll") for (int m = 0; m < 4; ++m) _Pragma("unroll") for (int n = 0; n < 2; ++n) \
        asm volatile("v_mfma_f32_16x16x128_f8f6f4 %0, %1, %2, %0" : "+v"(acc[ai][bj][m][n]) : "v"(Bt[n]), "v"(At[m])); __builtin_amdgcn_s_setprio(0); } while (0)
#define PG8_WAIT_V(n) asm volatile("s_waitcnt vmcnt(" #n ")" ::: "memory")
#define PG8_WAIT_L(n) asm volatile("s_waitcnt lgkmcnt(" #n ")" ::: "memory")
#define PG8_BAR __builtin_amdgcn_s_barrier()
#define PG8_SCHED __builtin_amdgcn_sched_barrier(0)
    Unit cur, nxt; int ui = 0;
    if (!S.next(0, cur)) return;
    cur.pm = uni(cur.pm); cur.pn = uni(cur.pn);
    const char* const gA = (const char*)uniptr(g.A); const char* const gB = (const char*)uniptr(g.Bt);
    Acc acc;
#pragma unroll
    for (int a = 0; a < 2; ++a)
#pragma unroll
        for (int b = 0; b < 2; ++b)
#pragma unroll
            for (int m = 0; m < 4; ++m)
#pragma unroll
                for (int n = 0; n < 2; ++n) acc[a][b][m][n] = (f32x4){0.f, 0.f, 0.f, 0.f};
    v8i At[4], B0[2], B1[2];
    const char* cA = GATHER ? gA : gA + (size_t)cur.pm * tstepA; const char* cB = gB + (size_t)cur.pn * tstepB;
    if constexpr (GATHER) { PG8_GROWS(cur, vA0, vA1); }
    PG8_STAGE(PG8_SB(0, 0), cB, voffB); PG8_STAGE(PG8_SB(0, 1), cB + hstepB, voffB);
    if constexpr (GATHER) { PG8_STAGE(PG8_SA(0, 0), cA, vA0); PG8_STAGE(PG8_SA(0, 1), cA, vA1); } else { PG8_STAGE(PG8_SA(0, 0), cA, voffA); PG8_STAGE(PG8_SA(0, 1), cA + hstepA, voffA); }
    if (wr == 1) PG8_BAR;
    PG8_WAIT_V(2); PG8_BAR;
    PG8_STAGE(PG8_SB(1, 0), cB + kstep, voffB); if constexpr (GATHER) PG8_STAGE(PG8_SA(1, 0), cA + kstep, vA0); else PG8_STAGE(PG8_SA(1, 0), cA + kstep, voffA); PG8_STAGE(PG8_SB(1, 1), cB + hstepB + kstep, voffB);
    PG8_WAIT_V(6); PG8_BAR;
    for (;;) {
        const bool has_next = uni((int)S.next(ui + 1, nxt)) != 0; nxt.pm = uni(nxt.pm); nxt.pn = uni(nxt.pn);
        const char* nA = GATHER ? cA : (has_next ? gA + (size_t)nxt.pm * tstepA : cA); const char* nB = has_next ? gB + (size_t)nxt.pn * tstepB : cB;
        for (int t = 0; t < nt; t += 2) {
            const bool last = (t == nt - 2);
            const char* a1 = cA + (size_t)(t + 1) * kstep;
            const char* a2 = last ? nA : cA + (size_t)(t + 2) * kstep; const char* b2 = last ? nB : cB + (size_t)(t + 2) * kstep;
            const char* a3 = a2 + kstep; const char* b3 = b2 + kstep;
            PG8_LDB(B0, 0, 0); PG8_LDB(B1, 0, 1); PG8_SCHED; PG8_LDA(At, 0, 0); if constexpr (GATHER) PG8_STAGE(PG8_SA(1, 1), a1, vA1); else PG8_STAGE(PG8_SA(1, 1), a1 + hstepA, voffA);
            if constexpr (GATHER) { if (last && has_next) PG8_GROWS(nxt, vA0, vA1); }
            PG8_WAIT_V(8); PG8_WAIT_L(0); PG8_BAR; PG8_MMA(0, 0, At, B0); PG8_MMA(0, 1, At, B1); PG8_BAR; PG8_SCHED;
            PG8_LDA(At, 0, 1); PG8_STAGE(PG8_SB(0, 0), b2, voffB); PG8_STAGE(PG8_SB(0, 1), b2 + hstepB, voffB); if constexpr (GATHER) PG8_STAGE(PG8_SA(0, 0), a2, vA0); else PG8_STAGE(PG8_SA(0, 0), a2, voffA);
            PG8_WAIT_V(8); PG8_WAIT_L(0); PG8_BAR; PG8_MMA(1, 0, At, B0); PG8_MMA(1, 1, At, B1); PG8_BAR; PG8_SCHED;
            PG8_LDB(B0, 1, 0); PG8_LDB(B1, 1, 1); PG8_SCHED; PG8_LDA(At, 1, 0); if constexpr (GATHER) PG8_STAGE(PG8_SA(0, 1), a2, vA1); else PG8_STAGE(PG8_SA(0, 1), a2 + hstepA, voffA);
            PG8_WAIT_V(8); PG8_WAIT_L(0); PG8_BAR; PG8_MMA(0, 0, At, B0); PG8_MMA(0, 1, At, B1); PG8_BAR; PG8_SCHED;
            PG8_LDA(At, 1, 1); PG8_STAGE(PG8_SB(1, 0), b3, voffB); PG8_STAGE(PG8_SB(1, 1), b3 + hstepB, voffB); if constexpr (GATHER) PG8_STAGE(PG8_SA(1, 0), a3, vA0); else PG8_STAGE(PG8_SA(1, 0), a3, voffA);
            PG8_WAIT_V(8); PG8_WAIT_L(0); PG8_BAR; PG8_MMA(1, 0, At, B0); PG8_MMA(1, 1, At, B1); PG8_BAR; PG8_SCHED;
        }
        asm volatile("s_nop 15\n\ts_nop 7" ::: "memory");
        if constexpr (ALIGN_EPI) { if (wr == 0) PG8_BAR; }
        E(acc, cur, wr, wc, fr, fq);
        if (!has_next) break;
#pragma unroll
        for (int a = 0; a < 2; ++a)
#pragma unroll
            for (int b = 0; b < 2; ++b)
#pragma unroll
                for (int m = 0; m < 4; ++m)
#pragma unroll
                    for (int n = 0; n < 2; ++n) acc[a][b][m][n] = (f32x4){0.f, 0.f, 0.f, 0.f};
        cur = nxt; cA = nA; cB = nB; ++ui;
        if constexpr (ALIGN_EPI) { if (wr == 1) PG8_BAR; }
    }
    PG8_WAIT_V(0);
    if constexpr (!ALIGN_EPI) { if (wr == 0) PG8_BAR; }
    PG8_BAR;
#undef PG8_GROWS
#undef PG8_SA
#undef PG8_SB
#undef PG8_STAGE
#undef PG8_FR
#undef PG8_LDA
#undef PG8_LDB
#undef PG8_MMA
#undef PG8_WAIT_V
#undef PG8_WAIT_L
#undef PG8_BAR
#undef PG8_SCHED
}

struct EpiBf16 {
    static constexpr bool PERM = true;
    bf16_t* O; int ldc; float scale;
    __device__ __forceinline__ void operator()(const Acc& acc, const Unit& u, int wr, int wc, int fr, int fq) const {
        const int row0 = u.pm * BM + wr * 64 + fr, col0 = u.pn * BM + wc * 32 + 8 * fq;
#pragma unroll
        for (int ai = 0; ai < 2; ++ai)
#pragma unroll
            for (int m = 0; m < 4; ++m) { bf16_t* rowp = O + (size_t)(row0 + ai * HALF + m * 16) * ldc + col0;
#pragma unroll
                for (int bj = 0; bj < 2; ++bj) { const f32x4 v0 = acc[ai][bj][m][0] * scale, v1 = acc[ai][bj][m][1] * scale;
                    u32x4 w; w.x = cvt_pk_bf16(v0[0], v0[1]); w.y = cvt_pk_bf16(v0[2], v0[3]); w.z = cvt_pk_bf16(v1[0], v1[1]); w.w = cvt_pk_bf16(v1[2], v1[3]);
                    *(u32x4*)(rowp + bj * HALF) = w; } }
    }
};
struct EpiP8 {
    static constexpr bool PERM = true;
    bf16_t* O; int ldc; float scale;
    __device__ __forceinline__ void operator()(const Acc& acc, const Unit& u, int wr, int wc, int fr, int fq) const {
        const int row0 = u.pm * BM + wr * 64 + fr;
        if (u.pn < G8_T0) { const int col0 = u.pn * BM + wc * 32 + 8 * fq;
#pragma unroll
            for (int ai = 0; ai < 2; ++ai)
#pragma unroll
                for (int m = 0; m < 4; ++m) { bf16_t* rowp = O + (size_t)(row0 + ai * HALF + m * 16) * ldc + col0;
#pragma unroll
                    for (int bj = 0; bj < 2; ++bj) { const f32x4 v0 = acc[ai][bj][m][0] * scale, v1 = acc[ai][bj][m][1] * scale;
                        u32x4 w; w.x = cvt_pk_bf16(v0[0], v0[1]); w.y = cvt_pk_bf16(v0[2], v0[3]); w.z = cvt_pk_bf16(v1[0], v1[1]); w.w = cvt_pk_bf16(v1[2], v1[3]);
                        *(u32x4*)(rowp + bj * HALF) = w; } }
        } else { const int g0 = u.pn * BM - C_GL + wc * 32 + 8 * fq; const float sg = scale * S8_G;
#pragma unroll
            for (int ai = 0; ai < 2; ++ai)
#pragma unroll
                for (int m = 0; m < 4; ++m) { unsigned char* rowp = (unsigned char*)(O + (size_t)(row0 + ai * HALF + m * 16) * ldc) + G8_OFF + g0;
#pragma unroll
                    for (int bj = 0; bj < 2; ++bj) { const f32x4 v0 = acc[ai][bj][m][0] * sg, v1 = acc[ai][bj][m][1] * sg;
                        u32x2 w; w.x = (unsigned)pk4_fp8(v0[0], v0[1], v0[2], v0[3]); w.y = (unsigned)pk4_fp8(v1[0], v1[1], v1[2], v1[3]);
                        *(u32x2*)(rowp + bj * HALF) = w; } }
        }
    }
};
struct EpiBf16G {
    static constexpr bool PERM = true;
    bf16_t* O; int ldc; float scale;
    __device__ __forceinline__ void operator()(const Acc& acc, const Unit& u, int wr, int wc, int fr, int fq) const {
        const int row0 = u.pm * BM + wr * 64 + fr, col0 = u.pn * BM + wc * 32 + 8 * fq;
        const bool gt = (u.pn == G8_T0 - 1);
#pragma unroll
        for (int ai = 0; ai < 2; ++ai)
#pragma unroll
            for (int m = 0; m < 4; ++m) { bf16_t* rowp = O + (size_t)(row0 + ai * HALF + m * 16) * ldc + col0;
#pragma unroll
                for (int bj = 0; bj < 2; ++bj) { const f32x4 v0 = acc[ai][bj][m][0] * scale, v1 = acc[ai][bj][m][1] * scale;
                    u32x4 w; w.x = cvt_pk_bf16(v0[0], v0[1]); w.y = cvt_pk_bf16(v0[2], v0[3]); w.z = cvt_pk_bf16(v1[0], v1[1]); w.w = cvt_pk_bf16(v1[2], v1[3]);
                    *(u32x4*)(rowp + bj * HALF) = w;
                    const int g = col0 + bj * HALF - C_GL;
                    if (gt && g >= 0) { u32x2 w8; w8.x = (unsigned)pk4_fp8(v0[0] * S8_G, v0[1] * S8_G, v0[2] * S8_G, v0[3] * S8_G); w8.y = (unsigned)pk4_fp8(v1[0] * S8_G, v1[1] * S8_G, v1[2] * S8_G, v1[3] * S8_G);
                        *(u32x2*)((unsigned char*)(O + (size_t)(row0 + ai * HALF + m * 16) * ldc) + G8_OFF + g) = w8; } } }
    }
};
struct EpiBf16Moe {
    static constexpr bool PERM = true;
    bf16_t* O; int ldc; int nper; float scale;
    __device__ __forceinline__ void operator()(const Acc& acc, const Unit& u, int wr, int wc, int fr, int fq) const {
        const int row0 = u.pm * BM + wr * 64 + fr, col0 = (u.pn % nper) * BM + wc * 32 + 8 * fq;
#pragma unroll
        for (int ai = 0; ai < 2; ++ai)
#pragma unroll
            for (int m = 0; m < 4; ++m) { bf16_t* rowp = O + (size_t)(row0 + ai * HALF + m * 16) * ldc + col0;
#pragma unroll
                for (int bj = 0; bj < 2; ++bj) { const f32x4 v0 = acc[ai][bj][m][0] * scale, v1 = acc[ai][bj][m][1] * scale;
                    u32x4 w; w.x = cvt_pk_bf16(v0[0], v0[1]); w.y = cvt_pk_bf16(v0[2], v0[3]); w.z = cvt_pk_bf16(v1[0], v1[1]); w.w = cvt_pk_bf16(v1[2], v1[3]);
                    *(u32x4*)(rowp + bj * HALF) = w; } }
    }
};
#define G8_DECODE(gl8, w2) do { const auto p0_ = __builtin_amdgcn_cvt_pk_f32_fp8((int)(w2).x, false), p1_ = __builtin_amdgcn_cvt_pk_f32_fp8((int)(w2).x, true), \
        p2_ = __builtin_amdgcn_cvt_pk_f32_fp8((int)(w2).y, false), p3_ = __builtin_amdgcn_cvt_pk_f32_fp8((int)(w2).y, true); \
        gl8[0] = p0_[0]; gl8[1] = p0_[1]; gl8[2] = p1_[0]; gl8[3] = p1_[1]; gl8[4] = p2_[0]; gl8[5] = p2_[1]; gl8[6] = p3_[0]; gl8[7] = p3_[1]; } while (0)
struct EpiGate {
    static constexpr bool PERM = true;
    bf16_t* Mo; const unsigned char* gate; int ldg; const float* bgate; bool ACCUM; float ascale;
    __device__ __forceinline__ void operator()(const Acc& acc, const Unit& u, int wr, int wc, int fr, int fq) const {
        const int row0 = u.pm * BM + wr * 64 + fr, col0 = u.pn * BM + wc * 32 + 8 * fq;
        f32x4 bv[2][2];
#pragma unroll
        for (int bj = 0; bj < 2; ++bj)
#pragma unroll
            for (int n = 0; n < 2; ++n) bv[bj][n] = *(const f32x4*)(bgate + col0 + bj * HALF + 4 * n);
#pragma unroll
        for (int ai = 0; ai < 2; ++ai) {
            u32x2 gw[4][2]; u32x4 pw[4][2];
#pragma unroll
            for (int m = 0; m < 4; ++m) { const size_t r = (size_t)(row0 + ai * HALF + m * 16);
#pragma unroll
                for (int bj = 0; bj < 2; ++bj) { gw[m][bj] = *(const u32x2*)(gate + r * ldg + col0 + bj * HALF);
                    pw[m][bj] = (u32x4){0u, 0u, 0u, 0u}; if (ACCUM) pw[m][bj] = *(const u32x4*)(Mo + r * D + col0 + bj * HALF); } }
            asm volatile("" ::: "memory");
#pragma unroll
            for (int m = 0; m < 4; ++m) { const size_t r = (size_t)(row0 + ai * HALF + m * 16);
#pragma unroll
                for (int bj = 0; bj < 2; ++bj) { float o[8], gl8[8]; G8_DECODE(gl8, gw[m][bj]);
#pragma unroll
                    for (int j = 0; j < 8; ++j) { const unsigned pword = pw[m][bj][j >> 1];
                        const float gl = gl8[j] * (1.0f / S8_G);
                        const float pv = __uint_as_float((j & 1) ? (pword & 0xffff0000u) : (pword << 16));
                        const float a = acc[ai][bj][m][j >> 2][j & 3] * ascale;
                        o[j] = pv + sigmoidf_(gl + bv[bj][j >> 2][j & 3]) * a; }
                    u32x4 w; w.x = cvt_pk_bf16(o[0], o[1]); w.y = cvt_pk_bf16(o[2], o[3]); w.z = cvt_pk_bf16(o[4], o[5]); w.w = cvt_pk_bf16(o[6], o[7]);
                    *(u32x4*)(Mo + r * D + col0 + bj * HALF) = w; } }
        }
    }
};
struct EpiGateLite {
    static constexpr bool PERM = true;
    bf16_t* Mo; const unsigned char* gate; int ldg; const float* bgate; bool ACCUM; float ascale;
    __device__ __forceinline__ void operator()(const Acc& acc, const Unit& u, int wr, int wc, int fr, int fq) const {
        const int row0 = u.pm * BM + wr * 64 + fr, col0 = u.pn * BM + wc * 32 + 8 * fq;
#pragma unroll
        for (int ai = 0; ai < 2; ++ai)
#pragma unroll
            for (int m = 0; m < 4; ++m) { const size_t r = (size_t)(row0 + ai * HALF + m * 16);
#pragma unroll
                for (int bj = 0; bj < 2; ++bj) {
                    const u32x2 gw = *(const u32x2*)(gate + r * ldg + col0 + bj * HALF);
                    u32x4 pw = (u32x4){0u, 0u, 0u, 0u}; if (ACCUM) pw = *(const u32x4*)(Mo + r * D + col0 + bj * HALF);
                    const f32x4 b0 = *(const f32x4*)(bgate + col0 + bj * HALF), b1 = *(const f32x4*)(bgate + col0 + bj * HALF + 4);
                    float o[8], gl8[8]; G8_DECODE(gl8, gw);
#pragma unroll
                    for (int j = 0; j < 8; ++j) { const unsigned pword = pw[j >> 1];
                        const float gl = gl8[j] * (1.0f / S8_G);
                        const float pv = __uint_as_float((j & 1) ? (pword & 0xffff0000u) : (pword << 16));
                        const float a = acc[ai][bj][m][j >> 2][j & 3] * ascale;
                        o[j] = pv + sigmoidf_(gl + ((j < 4) ? b0[j & 3] : b1[j & 3])) * a; }
                    u32x4 w; w.x = cvt_pk_bf16(o[0], o[1]); w.y = cvt_pk_bf16(o[2], o[3]); w.z = cvt_pk_bf16(o[4], o[5]); w.w = cvt_pk_bf16(o[6], o[7]);
                    *(u32x4*)(Mo + r * D + col0 + bj * HALF) = w; } }
    }
};
struct EpiResid {
    static constexpr bool PERM = true;
    const float* xi_lo; const float* xi_hi; const bf16_t* xi_bf; bf16_t* Xo; const float* gmod; int gstride;
    __device__ __forceinline__ void operator()(const Acc& acc, const Unit& u, int wr, int wc, int fr, int fq) const {
        const int row0 = u.pm * BM + wr * 64 + fr, col0 = u.pn * BM + wc * 32 + 8 * fq;
        const int rb = (u.pm * BM < TX) ? (u.pm * BM) / SEQ : NB;
        const float* xi = (u.pm * BM < TX) ? xi_lo : xi_hi;
        f32x4 gv[2][2];
#pragma unroll
        for (int bj = 0; bj < 2; ++bj)
#pragma unroll
            for (int n = 0; n < 2; ++n) gv[bj][n] = *(const f32x4*)(gmod + (size_t)rb * gstride + col0 + bj * HALF + 4 * n);
#pragma unroll
        for (int ai = 0; ai < 2; ++ai)
#pragma unroll
            for (int m = 0; m < 4; ++m) { const size_t off = (size_t)(row0 + ai * HALF + m * 16) * D + col0;
#pragma unroll
                for (int bj = 0; bj < 2; ++bj) { f32x4 b0, b1;
                    if (xi_bf) { const u32x4 w = *(const u32x4*)(xi_bf + off + bj * HALF); b0 = (f32x4){BF_LO(w.x), BF_HI(w.x), BF_LO(w.y), BF_HI(w.y)}; b1 = (f32x4){BF_LO(w.z), BF_HI(w.z), BF_LO(w.w), BF_HI(w.w)}; }
                    else { b0 = *(const f32x4*)(xi + off + bj * HALF); b1 = *(const f32x4*)(xi + off + bj * HALF + 4); }
                    const f32x4 v0 = b0 + gv[bj][0] * acc[ai][bj][m][0], v1 = b1 + gv[bj][1] * acc[ai][bj][m][1];
                    u32x4 w; w.x = cvt_pk_bf16(v0[0], v0[1]); w.y = cvt_pk_bf16(v0[2], v0[3]); w.z = cvt_pk_bf16(v1[0], v1[1]); w.w = cvt_pk_bf16(v1[2], v1[3]);
                    *(u32x4*)(Xo + off + bj * HALF) = w; }
                if (m == 3) asm volatile("" ::: "memory"); }
    }
};
struct EpiDelta {
    static constexpr bool PERM = true;
    bf16_t* DX; const float* gmod; int gstride;
    __device__ __forceinline__ void operator()(const Acc& acc, const Unit& u, int wr, int wc, int fr, int fq) const {
        const int row0 = u.pm * BM + wr * 64 + fr, col0 = u.pn * BM + wc * 32 + 8 * fq;
        const int rb = (u.pm * BM < TX) ? (u.pm * BM) / SEQ : NB;
        f32x4 gv[2][2];
#pragma unroll
        for (int bj = 0; bj < 2; ++bj)
#pragma unroll
            for (int n = 0; n < 2; ++n) gv[bj][n] = *(const f32x4*)(gmod + (size_t)rb * gstride + col0 + bj * HALF + 4 * n);
#pragma unroll
        for (int ai = 0; ai < 2; ++ai)
#pragma unroll
            for (int m = 0; m < 4; ++m) { bf16_t* rowp = DX + (size_t)(row0 + ai * HALF + m * 16) * D + col0;
#pragma unroll
                for (int bj = 0; bj < 2; ++bj) { const f32x4 v0 = acc[ai][bj][m][0] * gv[bj][0], v1 = acc[ai][bj][m][1] * gv[bj][1];
                    u32x4 w; w.x = cvt_pk_bf16(v0[0], v0[1]); w.y = cvt_pk_bf16(v0[2], v0[3]); w.z = cvt_pk_bf16(v1[0], v1[1]); w.w = cvt_pk_bf16(v1[2], v1[3]);
                    *(u32x4*)(rowp + bj * HALF) = w; } }
    }
};
struct EpiSwiglu8 {
    static constexpr bool PERM = true;
    unsigned char* O; float scale;
    __device__ __forceinline__ void operator()(const Acc& acc, const Unit& u, int wr, int wc, int fr, int fq) const {
        const int row0 = u.pm * BM + wr * 64 + fr, col0 = (u.pn & 3) * HALF + wc * 32 + 8 * fq;
#pragma unroll
        for (int ai = 0; ai < 2; ++ai)
#pragma unroll
            for (int m = 0; m < 4; ++m) { unsigned char* rowp = O + (size_t)(row0 + ai * HALF + m * 16) * DE + col0;
                float o[8];
#pragma unroll
                for (int j = 0; j < 8; ++j) { const float gg = acc[ai][0][m][j >> 2][j & 3] * scale, uu = acc[ai][1][m][j >> 2][j & 3] * scale; o[j] = gg * sigmoidr_(gg) * uu * S8_ACT; }
                u32x2 w; w.x = (unsigned)pk4_fp8(o[0], o[1], o[2], o[3]); w.y = (unsigned)pk4_fp8(o[4], o[5], o[6], o[7]);
                *(u32x2*)rowp = w; }
    }
};
}

namespace att {
constexpr int DV = 128, NW = 8, QBLK = 32, KVBLK = 64;
#define SBAR() __builtin_amdgcn_sched_barrier(0)
__device__ __forceinline__ int crow(int r, int hi) { return (r & 3) + 8 * (r >> 2) + 4 * hi; }
template <int DQK> __device__ __forceinline__ int kswz(int row, int colB) { return row * (DQK * 2) + (colB ^ ((row & 7) << 4)); }

template <int DQK> struct Cst { static constexpr float SCALE = (DQK == 128 ? 0.088388347648318440f : 0.072168783648703220f) / (S8_QK * S8_QK); };

template <int DQK>
__device__ __forceinline__ void partialSM(f32x16& p0, f32x16& p1, float& m_reg, float& mn, float& alpha) {
  constexpr float SCALE = Cst<DQK>::SCALE, THR = 3.f;
  constexpr float C = SCALE * 1.4426950408889634f;
  float pmax = p0[0];
#pragma unroll
  for (int r = 1; r < 16; ++r) pmax = fmaxf(pmax, p0[r]);
#pragma unroll
  for (int r = 0; r < 16; ++r) pmax = fmaxf(pmax, p1[r]);
  { auto rr = __builtin_amdgcn_permlane32_swap(__float_as_uint(pmax), __float_as_uint(pmax), false, false);
    pmax = fmaxf(__uint_as_float(rr[0]), __uint_as_float(rr[1])); }
  if (__builtin_expect(__all(pmax - m_reg <= THR / SCALE), 1)) { mn = m_reg; alpha = 1.f; }
  else { mn = fmaxf(m_reg, pmax); alpha = __builtin_amdgcn_exp2f((m_reg - mn) * C); m_reg = mn; }
  float mnC = 4.0f - mn * C;
#pragma unroll
  for (int r = 0; r < 16; ++r) p0[r] = fmaf(p0[r], C, mnC);
#pragma unroll
  for (int r = 0; r < 16; ++r) p1[r] = fmaf(p1[r], C, mnC);
#pragma unroll
  for (int r = 0; r < 16; ++r) p0[r] = __builtin_amdgcn_exp2f(p0[r]);
}
__device__ __forceinline__ void finishSM(f32x16& p0, f32x16& p1, float alpha, float& l_reg, bf16x8& pa0, bf16x8& pa1, bf16x8& pa2, bf16x8& pa3) {
#pragma unroll
  for (int r = 0; r < 16; ++r) p1[r] = __builtin_amdgcn_exp2f(p1[r]);
  float ps = 0;
#pragma unroll
  for (int r = 0; r < 16; ++r) ps += p0[r];
#pragma unroll
  for (int r = 0; r < 16; ++r) ps += p1[r];
  { auto rr = __builtin_amdgcn_permlane32_swap(__float_as_uint(ps), __float_as_uint(ps), false, false);
    ps = __uint_as_float(rr[0]) + __uint_as_float(rr[1]); }
  l_reg = l_reg * alpha + ps;
#define PK4(P, BASE, OUT) do { unsigned a0 = cvt_pk_bf16(P[BASE + 0], P[BASE + 1]), a1 = cvt_pk_bf16(P[BASE + 2], P[BASE + 3]);   \
    unsigned b0 = cvt_pk_bf16(P[BASE + 4], P[BASE + 5]), b1 = cvt_pk_bf16(P[BASE + 6], P[BASE + 7]);                              \
    auto r0 = __builtin_amdgcn_permlane32_swap(a0, b0, false, false); auto r1 = __builtin_amdgcn_permlane32_swap(a1, b1, false, false); \
    u32x4 w = {r0[0], r1[0], r0[1], r1[1]}; OUT = *reinterpret_cast<bf16x8*>(&w); } while (0)
  PK4(p0, 0, pa0); PK4(p0, 8, pa1); PK4(p1, 0, pa2); PK4(p1, 8, pa3);
#undef PK4
}
typedef int v8i_a __attribute__((ext_vector_type(8)));
typedef int v4i_a __attribute__((ext_vector_type(4)));
template <int DQK> __device__ __forceinline__ int kpos(int pc, int k) { return DQK == 128 ? (pc ^ ((k >> 1) & 7)) : (pc ^ ((k >> 2) & 3)); }
template <int DQK>
__device__ __forceinline__ void qkt(f32x16& p0, f32x16& p1, const char* Ks, const v8i_a* qf, int r32, int hi) {
  p0 = f32x16{}; p1 = f32x16{};
#pragma unroll
  for (int ks = 0; ks < DQK / 64; ++ks) { const int pc = ks * 4 + hi * 2;
    const v4i_a a0 = *reinterpret_cast<const v4i_a*>(Ks + r32 * DQK + (kpos<DQK>(pc, r32) << 4)), a1 = *reinterpret_cast<const v4i_a*>(Ks + r32 * DQK + (kpos<DQK>(pc + 1, r32) << 4));
    const v4i_a c0 = *reinterpret_cast<const v4i_a*>(Ks + (32 + r32) * DQK + (kpos<DQK>(pc, 32 + r32) << 4)), c1 = *reinterpret_cast<const v4i_a*>(Ks + (32 + r32) * DQK + (kpos<DQK>(pc + 1, 32 + r32) << 4));
    const v8i_a k0 = __builtin_shufflevector(a0, a1, 0, 1, 2, 3, 4, 5, 6, 7), k1 = __builtin_shufflevector(c0, c1, 0, 1, 2, 3, 4, 5, 6, 7);
    p0 = __builtin_amdgcn_mfma_scale_f32_32x32x64_f8f6f4(k0, qf[ks], p0, 0, 0, 0, 0, 0, 0);
    p1 = __builtin_amdgcn_mfma_scale_f32_32x32x64_f8f6f4(k1, qf[ks], p1, 0, 0, 0, 0, 0, 0); }
}
__device__ __forceinline__ int v_st(int k, int c) { const int kk = (k & ~0xC) | ((k & 4) << 1) | ((k & 8) >> 1); return ((kk >> 3) * 4 + (c >> 5)) * 512 + ((kk & 7) * 32 + (c & 31)) * 2; }
__device__ __forceinline__ int v_rd_base(int lane) { return ((lane & 3) << 3) | (((lane >> 2) & 3) << 6) | (((lane >> 4) & 1) << 5) | (((lane >> 5) & 1) << 8); }
constexpr int v_rd_off(int d0, int ks, int half) { return d0 * 512 + ks * 4096 + half * 2048; }
template <int OFF> __device__ __forceinline__ s16x4 tr_read(int vb) {
  s16x4 r; asm volatile("ds_read_b64_tr_b16 %0, %1 offset:%2" : "=&v"(r) : "v"(vb), "i"(OFF) : "memory"); return r;
}
template <int D0> __device__ __forceinline__ void pv_one(f32x16& od, int vb, bf16x8 pa0, bf16x8 pa1, bf16x8 pa2, bf16x8 pa3) {
  const s16x4 l0 = tr_read<v_rd_off(D0, 0, 0)>(vb), h0 = tr_read<v_rd_off(D0, 0, 1)>(vb), l1 = tr_read<v_rd_off(D0, 1, 0)>(vb), h1 = tr_read<v_rd_off(D0, 1, 1)>(vb);
  const s16x4 l2 = tr_read<v_rd_off(D0, 2, 0)>(vb), h2 = tr_read<v_rd_off(D0, 2, 1)>(vb), l3 = tr_read<v_rd_off(D0, 3, 0)>(vb), h3 = tr_read<v_rd_off(D0, 3, 1)>(vb);
  asm volatile("s_waitcnt lgkmcnt(0)" ::: "memory"); SBAR();
#define PK(L, H) (bf16x8){L[0], L[1], L[2], L[3], H[0], H[1], H[2], H[3]}
  od = __builtin_amdgcn_mfma_f32_32x32x16_bf16(pa0, PK(l0, h0), od, 0, 0, 0);
  od = __builtin_amdgcn_mfma_f32_32x32x16_bf16(pa1, PK(l1, h1), od, 0, 0, 0);
  od = __builtin_amdgcn_mfma_f32_32x32x16_bf16(pa2, PK(l2, h2), od, 0, 0, 0);
  od = __builtin_amdgcn_mfma_f32_32x32x16_bf16(pa3, PK(l3, h3), od, 0, 0, 0);
#undef PK
}
__device__ __forceinline__ void pv_d0(f32x16* o, int vb, bf16x8 pa0, bf16x8 pa1, bf16x8 pa2, bf16x8 pa3) {
  pv_one<0>(o[0], vb, pa0, pa1, pa2, pa3); pv_one<1>(o[1], vb, pa0, pa1, pa2, pa3); pv_one<2>(o[2], vb, pa0, pa1, pa2, pa3); pv_one<3>(o[3], vb, pa0, pa1, pa2, pa3);
}

__device__ __forceinline__ void finishSM8(f32x16& p0, f32x16& p1, float alpha, float& l_reg, v8i_a& pf) {
#pragma unroll
  for (int r = 0; r < 16; ++r) p1[r] = __builtin_amdgcn_exp2f(p1[r]);
  float ps = 0;
#pragma unroll
  for (int r = 0; r < 16; ++r) ps += p0[r];
#pragma unroll
  for (int r = 0; r < 16; ++r) ps += p1[r];
  { auto rr = __builtin_amdgcn_permlane32_swap(__float_as_uint(ps), __float_as_uint(ps), false, false);
    ps = __uint_as_float(rr[0]) + __uint_as_float(rr[1]); }
  l_reg = l_reg * alpha + ps;
#pragma unroll
  for (int i = 0; i < 4; ++i) {
    unsigned d0 = (unsigned)__builtin_amdgcn_cvt_pk_fp8_f32(p0[4 * i], p0[4 * i + 1], 0, false); d0 = (unsigned)__builtin_amdgcn_cvt_pk_fp8_f32(p0[4 * i + 2], p0[4 * i + 3], (int)d0, true);
    unsigned d1 = (unsigned)__builtin_amdgcn_cvt_pk_fp8_f32(p1[4 * i], p1[4 * i + 1], 0, false); d1 = (unsigned)__builtin_amdgcn_cvt_pk_fp8_f32(p1[4 * i + 2], p1[4 * i + 3], (int)d1, true);
    auto rr = __builtin_amdgcn_permlane32_swap(d0, d1, false, false);
    pf[2 * i] = (int)rr[0]; pf[2 * i + 1] = (int)rr[1]; }
}
__device__ __forceinline__ void pv8(f32x16* o, const char* Vs, const v8i_a pf, int r32, int hi) {
  const int base = r32 * 64 + (((2 * hi) ^ ((r32 >> 2) & 3)) << 4);
#pragma unroll
  for (int d0 = 0; d0 < 4; ++d0) {
    const v4i_a lo = *reinterpret_cast<const v4i_a*>(Vs + base + d0 * 2048), hh = *reinterpret_cast<const v4i_a*>(Vs + (base ^ 16) + d0 * 2048);
    const v8i_a vf = __builtin_shufflevector(lo, hh, 0, 1, 2, 3, 4, 5, 6, 7);
    o[d0] = __builtin_amdgcn_mfma_scale_f32_32x32x64_f8f6f4(pf, vf, o[d0], 0, 0, 0, 0, 0, 0); }
}
constexpr int LDO = 1024;
template <int DQK, int SDEPTH>
__device__ __forceinline__ void attn_dense_body(const unsigned char* __restrict__ Qb, const unsigned char* __restrict__ Kh, const unsigned char* __restrict__ Vt, int vpitch,
                                                unsigned char* __restrict__ Ob, int seq, char* lds) {
  constexpr int SHM_V = KVBLK * DV, SHM_K = KVBLK * DQK, PPR = DQK / 16, NKC = (KVBLK * PPR + 511) / 512;
  const int tid = ltid(), wid = tid >> 6, lane = tid & 63, r32 = lane & 31, hi = lane >> 5;
  char* V_lds = lds; char* K_lds = lds + 2 * SHM_V;
  float* ws = (float*)(lds + 2 * SHM_V + 2 * SHM_K) + wid * 64; float* li_l = ws; float* al_l = ws + 32;
  float m_reg = -1e30f, l_reg = 0; f32x16 o[4] = {}; v8i_a qf[DQK / 64];
  const unsigned char* Qw = Qb + (long)(wid * QBLK + r32) * DQK + hi * 32;
#pragma unroll
  for (int ks = 0; ks < DQK / 64; ++ks) { const v4i_a lo = *reinterpret_cast<const v4i_a*>(Qw + ks * 64), hh = *reinterpret_cast<const v4i_a*>(Qw + ks * 64 + 16); qf[ks] = __builtin_shufflevector(lo, hh, 0, 1, 2, 3, 4, 5, 6, 7); }
  const int vd = tid >> 2, vpc = tid & 3, vst = vd * 64 + ((vpc ^ ((vd >> 2) & 3)) << 4);
  const unsigned char* Vsrc = Vt + (long)vd * vpitch + vpc * 16;
  struct { v4i_a vs; v4i_a ks[NKC]; } sr_[SDEPTH];
#define KID(q_) (tid + (q_) * 512)
#define KROW(q_) (KID(q_) / PPR)
#define KPC(q_) (KID(q_) % PPR)
#define KOK(q_) (NKC * 512 == KVBLK * PPR || (q_) + 1 < NKC || KID(q_) < KVBLK * PPR)
#define SLOAD(i, k0) do { sr_[i].vs = *reinterpret_cast<const v4i_a*>(Vsrc + (k0)); \
    _Pragma("unroll") for (int q_ = 0; q_ < NKC; ++q_) if (KOK(q_)) sr_[i].ks[q_] = *reinterpret_cast<const v4i_a*>(Kh + (long)((k0) + KROW(q_)) * DQK + KPC(q_) * 16); } while (0)
#define SWRITE(b, i) do { *(v4i_a*)(V_lds + (b) * SHM_V + vst) = sr_[i].vs; \
    _Pragma("unroll") for (int q_ = 0; q_ < NKC; ++q_) if (KOK(q_)) *(v4i_a*)(K_lds + (b) * SHM_K + KROW(q_) * DQK + (kpos<DQK>(KPC(q_), KROW(q_)) << 4)) = sr_[i].ks[q_]; } while (0)
#define SWAIT() do { if constexpr (SDEPTH == 2) { if constexpr (NKC == 1) asm volatile("s_waitcnt vmcnt(2)" ::: "memory"); else asm volatile("s_waitcnt vmcnt(3)" ::: "memory"); } \
    else asm volatile("s_waitcnt vmcnt(0)" ::: "memory"); } while (0)
#define RESC(a) do { if (__any((a) < 1.f)) { if (hi == 0) al_l[r32] = (a); asm volatile("s_waitcnt lgkmcnt(0)" ::: "memory"); \
    _Pragma("unroll") for (int d = 0; d < 4; ++d) _Pragma("unroll") for (int r = 0; r < 16; ++r) o[d][r] *= al_l[crow(r, hi)]; } } while (0)
#define QKT(P0, P1, KS) qkt<DQK>(P0, P1, KS, qf, r32, hi)
  f32x16 pA0, pA1, pB0, pB1; float mnA, mnB, alA, alB; v8i_a pf; const int NT = seq / KVBLK;
  constexpr int SE = 0, SO = SDEPTH - 1;
  SLOAD(SE, 0); asm volatile("s_waitcnt vmcnt(0)" ::: "memory"); SWRITE(0, SE); __syncthreads();
  QKT(pA0, pA1, K_lds); partialSM<DQK>(pA0, pA1, m_reg, mnA, alA);
  SLOAD(SO, KVBLK); if constexpr (SDEPTH == 2) { if (2 < NT) SLOAD(SE, 2 * KVBLK); }
  SWAIT(); SWRITE(1, SO); __syncthreads();
  for (int j = 1; j + 1 < NT; j += 2) {
    SBAR(); QKT(pB0, pB1, K_lds + SHM_K);
    finishSM8(pA0, pA1, alA, l_reg, pf); SBAR();
    SLOAD(SO, (j + SDEPTH) * KVBLK); SBAR();
    pv8(o, V_lds, pf, r32, hi); partialSM<DQK>(pB0, pB1, m_reg, mnB, alB);
    __syncthreads(); SWAIT(); SWRITE(0, SE);
    RESC(alB); __syncthreads();
    SBAR(); QKT(pA0, pA1, K_lds);
    finishSM8(pB0, pB1, alB, l_reg, pf); SBAR();
    if (SDEPTH == 1 || j + 3 < NT) SLOAD(SE, (j + 1 + SDEPTH) * KVBLK); SBAR();
    pv8(o, V_lds + SHM_V, pf, r32, hi); partialSM<DQK>(pA0, pA1, m_reg, mnA, alA);
    __syncthreads(); SWAIT(); SWRITE(1, SO);
    RESC(alA); __syncthreads();
  }
  SBAR(); QKT(pB0, pB1, K_lds + SHM_K);
  finishSM8(pA0, pA1, alA, l_reg, pf); SBAR();
  pv8(o, V_lds, pf, r32, hi); partialSM<DQK>(pB0, pB1, m_reg, mnB, alB);
  __syncthreads(); RESC(alB);
  finishSM8(pB0, pB1, alB, l_reg, pf); SBAR();
  pv8(o, V_lds + SHM_V, pf, r32, hi);
  if (hi == 0) li_l[r32] = l_reg; asm volatile("s_waitcnt lgkmcnt(0)" ::: "memory");
  float rli[16];
#pragma unroll
  for (int r = 0; r < 16; ++r) rli[r] = __builtin_amdgcn_rcpf(li_l[crow(r, hi)]) * (S8_Y / S8_V);
  unsigned char* Ow = Ob + (long)(wid * QBLK) * LDO;
#pragma unroll
  for (int r = 0; r < 16; ++r) { int orow = crow(r, hi);
#pragma unroll
    for (int d0 = 0; d0 < 4; ++d0) Ow[(long)orow * LDO + d0 * 32 + r32] = (unsigned char)(__builtin_amdgcn_cvt_pk_fp8_f32(o[d0][r] * rli[r], 0.f, 0, false) & 0xff); }
  asm volatile("s_waitcnt vmcnt(0) lgkmcnt(0)" ::: "memory"); __syncthreads();
#undef KID
#undef KROW
#undef KPC
#undef KOK
#undef SLOAD
#undef SWRITE
#undef SWAIT
#undef RESC
#undef QKT
}
#undef SBAR
}

constexpr size_t al256(size_t x) { return (x + 255) & ~(size_t)255; }
constexpr size_t WS_CTL   = 0;
constexpr size_t CTL_BYTES = 65536;
constexpr size_t CW_BAR = 0;
constexpr size_t CW_CNT = 4096;
constexpr size_t WS_MODV  = WS_CTL + CTL_BYTES;
constexpr size_t WS_WR    = WS_MODV + al256((size_t)2 * 5 * 12288 * 4);
constexpr size_t WS_ROPEA = WS_WR + (size_t)2 * 64 * 3 * 2 * 64 * 16;
constexpr size_t WS_ROPEC = WS_ROPEA + (size_t)4096 * 128 * 4;
constexpr size_t WS_W     = WS_ROPEC + (size_t)4096 * 64 * 4;
constexpr size_t WL_IN = 0, WL_UKV = WL_IN + (size_t)INCP * D * 2, WL_UQ = WL_UKV + (size_t)2048 * 256 * 2, WL_OA = WL_UQ + (size_t)1536 * 512 * 2,
                 WL_OB = WL_OA + (size_t)2048 * 1024 * 2, WL_OC = WL_OB + (size_t)2048 * 1024 * 2, WL_O = WL_OC + (size_t)2048 * 1024 * 2,
                 WL_GU = WL_O + (size_t)D * D * 2, WL_DN = WL_GU + (size_t)NE * 1024 * D * 2, WL_IN8 = WL_DN + (size_t)NE * D * DE * 2, WL_SIZE = WL_IN8 + (size_t)INCP * D;
constexpr int F8_LO = 9, F8_HI = 22; static_assert(F8_HI == G8_T0 && C_GL >= (G8_T0 - 1) * 256 && C_GL % 8 == 0, "gate-logit byte image");
constexpr size_t WS_X1    = WS_W + 2 * WL_SIZE;
constexpr size_t WS_X2    = WS_X1 + (size_t)MT * D * 4;
constexpr size_t WS_H     = WS_X2 + (size_t)MT * D * 4;
constexpr size_t WS_P     = WS_H + (size_t)MT * D * 2;
constexpr size_t WS_XS    = WS_P;
constexpr size_t WS_ACT   = WS_XS + (size_t)MAXSLOT * D * 2;
constexpr size_t WS_YS    = WS_ACT + (size_t)MAXSLOT * DE * 2;
static_assert(WS_YS + (size_t)MAXSLOT * D * 2 <= WS_P + (size_t)MT * INCP * 2, "MoE overlay must fit in P");
constexpr size_t WS_KA    = WS_P + (size_t)MT * INCP * 2;
constexpr size_t WS_VA    = WS_KA + (size_t)NB * 2 * LKV * 128 * 2;
constexpr size_t WS_QA    = WS_VA + (size_t)NB * 2 * LKV * 128 * 2;
constexpr size_t WS_CKVN  = WS_QA + (size_t)NB * 8 * LKV * 128 * 2;
constexpr size_t WS_CQN   = WS_CKVN + (size_t)MT * 256 * 2;
constexpr size_t WS_YCAT  = WS_CQN + (size_t)MT * 512 * 2;
constexpr size_t WS_KVUP  = WS_YCAT + (size_t)3 * MT * 1024 * 2;
constexpr size_t WS_QUP   = WS_KVUP + (size_t)MT * 2048 * 2;
constexpr size_t WS_KC    = WS_QUP + (size_t)MT * 1536 * 2;
constexpr size_t WS_QC    = WS_KC + (size_t)NB * 8 * LKV * 192 * 2;
constexpr size_t WS_VC    = WS_QC + (size_t)NB * 8 * LKV * 192 * 2;
constexpr size_t WS_M     = WS_VC + (size_t)NB * 8 * LKV * 128 * 2;
constexpr size_t WS_RTE   = WS_M + (size_t)MT * D * 2;
constexpr size_t WS_RTP   = WS_RTE + (size_t)MT * 2 * 4;
constexpr size_t WS_RTS   = WS_RTP + (size_t)MT * 2 * 4;
constexpr size_t WS_RTW   = WS_RTS + (size_t)MT * 2 * 4;
constexpr size_t WS_ELIST = WS_RTW + (size_t)MT * 2 * 4;
constexpr size_t WS_H8    = WS_ELIST + (size_t)NE * MT * 4;
constexpr size_t WS_END   = WS_H8 + (size_t)MT * D;

constexpr int LDS_STAGE = 131072, LDS_MISC = 2048, LDS_BYTES = LDS_STAGE + LDS_MISC;
constexpr int MISC_NBLK = 64, MISC_BLKE = 128, MISC_FBLK = 1024, MISC_ECNT = 1152, MISC_TMPB = 1280;

struct CvtJob { const float* src; bf16_t* dst; int K, N, Npad, batch, mode, tile0; float scale; int ld; };
constexpr int NJOBS = 22;
struct Params {
    const float* in[29];
    float* out;
    unsigned char* ws;
    CvtJob jobs[NJOBS];
    int total_tiles, ph_lo, ph_hi, tiles_l0;
};
enum { I_X = 0, I_C, I_CTX, I_CCTX, I_WMOD, I_BMOD, I_NORM1, I_NORM2, I_WIN, I_GQN, I_GKN, I_MQLN, I_WUQ, I_MKVLN, I_WUKV, I_MQN, I_MKN, I_CONVW, I_WOA, I_WOB, I_WOC,
       I_BGATE, I_WO, I_WGROUP, I_BGROUP, I_WROUTER, I_BROUTER, I_WGU, I_WDOWN };

__device__ __forceinline__ void cvt_tiles(const Params& P, LAS unsigned char* lds, int w0, int step, int wend) {
    const int tid = ltid();
    LAS float* tile = (LAS float*)lds;
    const int kk = tid >> 5, nn = (tid & 31) * 4;
    f32x4 ld[8];
    struct TJ { const float* src; bf16_t* dst; int K, N, ld, mode, k0, n0; float scale; };
    auto decode = [&](int w, TJ& t) {
        int j = 0;
#pragma unroll 1
        for (int q = 1; q < NJOBS; ++q) if (w >= P.jobs[q].tile0) j = q;
        const CvtJob jb = P.jobs[j];
        const int local = w - jb.tile0, tk_n = jb.K >> 7, tpm = tk_n * (jb.Npad >> 7);
        const int e = local / tpm, rem = local % tpm, tn = rem / tk_n, tk = rem % tk_n;
        t.ld = jb.ld; t.src = jb.src + (size_t)e * jb.K * jb.ld; t.dst = (jb.mode & 2) ? (bf16_t*)((unsigned char*)jb.dst + (size_t)e * jb.Npad * jb.K) : jb.dst + (size_t)e * jb.Npad * jb.K; t.scale = jb.scale; t.K = jb.K; t.N = jb.N; t.mode = jb.mode; t.k0 = tk * 128; t.n0 = tn * 128; };
    auto issue = [&](const TJ& t) {
#pragma unroll
        for (int p = 0; p < 8; ++p) { ld[p] = (f32x4){0.f, 0.f, 0.f, 0.f}; if (t.n0 + nn < t.N) ld[p] = *(const f32x4*)(t.src + (size_t)(t.k0 + kk + 16 * p) * t.ld + t.n0 + nn); } };
    TJ cur, nxt; int w = w0; bool have = w < wend;
    if (have) { decode(w, cur); issue(cur); }
    while (have) {
#pragma unroll
        for (int p = 0; p < 8; ++p) { LAS float* t = tile + (kk + 16 * p) * 129 + nn; t[0] = ld[p][0]; t[1] = ld[p][1]; t[2] = ld[p][2]; t[3] = ld[p][3]; }
        __syncthreads();
        const int wn = w + step; const bool hn = wn < wend;
        if (hn) { decode(wn, nxt); issue(nxt); }
        { const int nl = tid >> 2; const int n = cur.n0 + nl; int drow = n;
          if (cur.mode & 1) { const int jj = (n < DE) ? n : n - DE; drow = (jj >> 7) * 256 + ((n < DE) ? 0 : 128) + (jj & 127); }
          if (cur.mode & 2) { unsigned char* dp = (unsigned char*)cur.dst + (size_t)drow * cur.K + cur.k0; const float sc = cur.scale;
#pragma unroll
            for (int j = 0; j < 4; ++j) { const int kc = (tid & 3) * 8 + 32 * j; float v[8];
#pragma unroll
                for (int i = 0; i < 8; ++i) v[i] = tile[(kc + i) * 129 + nl] * sc;
                u32x2 o; o.x = (unsigned)pk4_fp8(v[0], v[1], v[2], v[3]); o.y = (unsigned)pk4_fp8(v[4], v[5], v[6], v[7]);
                *(u32x2*)(dp + kc) = o; }
          } else {
          bf16_t* dp = cur.dst + (size_t)drow * cur.K + cur.k0;
#pragma unroll
          for (int j = 0; j < 4; ++j) { const int kc = (tid & 3) * 8 + 32 * j; float v[8];
#pragma unroll
              for (int i = 0; i < 8; ++i) v[i] = tile[(kc + i) * 129 + nl];
              u32x4 o; o.x = cvt_pk_bf16(v[0], v[1]); o.y = cvt_pk_bf16(v[2], v[3]); o.z = cvt_pk_bf16(v[4], v[5]); o.w = cvt_pk_bf16(v[6], v[7]);
              *(u32x4*)(dp + kc) = o; } } }
        __syncthreads();
        cur = nxt; w = wn; have = hn;
    }
}

__device__ __forceinline__ void ph_prologue(const Params& P, LAS unsigned char* lds) {
    unsigned char* const ws = lptr(P.ws);
    const int tid = ltid(), G = gridDim.x, bx = blockIdx.x, lane = tid & 63, wid = tid >> 6;
    {
        float* ropeA = (float*)(ws + WS_ROPEA); float* ropeC = (float*)(ws + WS_ROPEC); float* WR = (float*)(ws + WS_WR);
        for (int i = bx * 512 + tid; i < SEQ * 64; i += G * 512) { const int s = i >> 6, a = i & 63; const float pos = (a < 32) ? (float)(s >> 6) : (float)(s & 63);
            const float inv = powf(10000.0f, -(float)(a & 31) / 32.0f); const float ang = pos * inv; ropeA[s * 128 + a] = cosf(ang); ropeA[s * 128 + 64 + a] = sinf(ang); }
        for (int i = bx * 512 + tid; i < SEQ * 32; i += G * 512) { const int s = i >> 5, a = i & 31; const float pos = (a < 16) ? (float)(s >> 6) : (float)(s & 63);
            const float inv = powf(10000.0f, -(float)(a & 15) / 16.0f); const float ang = pos * inv; ropeC[s * 64 + a] = cosf(ang); ropeC[s * 64 + 32 + a] = sinf(ang); }
        for (int i = bx * 512 + tid; i < 2 * 64 * 3 * 64 * 8; i += G * 512) {
            const int j = i & 7, ln = (i >> 3) & 63, t = i >> 9, nt = t % 3, ks = (t / 3) & 63, l = t / 192;
            const int k = ks * 32 + 8 * (ln >> 4) + j, o = nt * 16 + (ln & 15);
            float v = 0.f; if (o < 32) v = P.in[I_WROUTER][((size_t)l * D + k) * NE + o]; else if (o < 36) v = P.in[I_WGROUP][((size_t)l * D + k) * 4 + (o - 32)];
            const unsigned hb = cvt_pk_bf16(v, 0.f) & 0xffffu, lb = cvt_pk_bf16(v - __uint_as_float(hb << 16), 0.f) & 0xffffu;
            bf16_t* wr = (bf16_t*)WR + ((size_t)((l * 64 + ks) * 3 + nt) * 2 * 64 + ln) * 8 + j;
            wr[0] = (bf16_t)hb; wr[64 * 8] = (bf16_t)lb; }
    }
    if (bx < 192) {
        const int l = bx / 96, cg = bx % 96, c4 = lane & 31, ksub = lane >> 5;
        LAS float* actL = (LAS float*)lds; LAS float* red = (LAS float*)(lds + 40960);
        for (int i = tid; i < 5 * D; i += 512) { const int r = i / D, k = i % D; const float v = (r < 4) ? P.in[I_C][r * D + k] : P.in[I_CCTX][k]; actL[i] = v / (1.0f + __expf(-v)); }
        __syncthreads();
        f32x4 acc[5];
#pragma unroll
        for (int r = 0; r < 5; ++r) acc[r] = (f32x4){0.f, 0.f, 0.f, 0.f};
        const float* wp = P.in[I_WMOD] + ((size_t)l * D + wid * 256 + ksub) * 12288 + cg * 128 + c4 * 4; const LAS float* ap = actL + wid * 256 + ksub;
        f32x4 wv[8], wn[8];
#pragma unroll
        for (int q = 0; q < 8; ++q) wv[q] = *(const f32x4*)(wp + (size_t)q * 2 * 12288);
        for (int j = 0; j < 128; j += 8) {
            if (j + 8 < 128) {
#pragma unroll
                for (int q = 0; q < 8; ++q) wn[q] = *(const f32x4*)(wp + (size_t)(j + 8 + q) * 2 * 12288); }
            __builtin_amdgcn_sched_barrier(0);
#pragma unroll
            for (int q = 0; q < 8; ++q)
#pragma unroll
                for (int r = 0; r < 5; ++r) acc[r] += ap[r * D + (j + q) * 2] * wv[q];
#pragma unroll
            for (int q = 0; q < 8; ++q) wv[q] = wn[q];
        }
#pragma unroll
        for (int r = 0; r < 5; ++r) *(LAS f32x4*)(red + ((wid * 2 + ksub) * 5 + r) * 128 + c4 * 4) = acc[r];
        __syncthreads();
        float* modv = (float*)(ws + WS_MODV);
        for (int i = tid; i < 5 * 128; i += 512) { const int r = i >> 7, cc = i & 127; float sum = 0.f;
#pragma unroll
            for (int w = 0; w < 16; ++w) sum += red[(w * 5 + r) * 128 + cc];
            modv[((size_t)l * 5 + r) * 12288 + cg * 128 + cc] = sum + P.in[I_BMOD][l * 12288 + cg * 128 + cc]; }
        __syncthreads();
    }
    cvt_tiles(P, lds, bx, G, P.tiles_l0);
}

template <bool TO_LDS, bool WBF, bool W8> __device__ __forceinline__ void norm_mod_store(const f32x4 (&xv)[8], const float* gain, const float* sc, const float* sh, bf16_t* hrow, unsigned char* h8row, LAS float* lrow, int lane) {
    float ss = 0.f;
#pragma unroll
    for (int i = 0; i < 8; ++i) ss += xv[i][0] * xv[i][0] + xv[i][1] * xv[i][1] + xv[i][2] * xv[i][2] + xv[i][3] * xv[i][3];
    ss = wave_sum(ss);
    const float rs = 1.0f / sqrtf(ss * (1.0f / D) + EPS);
#pragma unroll
    for (int i = 0; i < 8; ++i) { const int c = i * 256 + lane * 4;
        const f32x4 g = *(const f32x4*)(gain + c), s1 = *(const f32x4*)(sc + c), s0 = *(const f32x4*)(sh + c);
        const f32x4 y = (xv[i] * rs) * g * (s1 + 1.0f) + s0;
        if constexpr (WBF) { u32x2 w; w.x = cvt_pk_bf16(y[0], y[1]); w.y = cvt_pk_bf16(y[2], y[3]); *(u32x2*)(hrow + c) = w; }
        if constexpr (W8) *(int*)(h8row + c) = pk4_fp8(y[0] * S8_H, y[1] * S8_H, y[2] * S8_H, y[3] * S8_H);
        if constexpr (TO_LDS) *(LAS f32x4*)(lrow + c) = y; }
}
struct ModVec { f32x4 a[8], b[8]; };
__device__ __forceinline__ void modvec_load(ModVec& m, const float* gain, const float* sc, const float* sh, int lane) {
#pragma unroll
    for (int i = 0; i < 8; ++i) { const int c = i * 256 + lane * 4; m.a[i] = *(const f32x4*)(gain + c) * (*(const f32x4*)(sc + c) + 1.0f); m.b[i] = *(const f32x4*)(sh + c); }
}
template <bool TO_LDS, bool WBF, bool W8> __device__ __forceinline__ void norm_mod_store2(const f32x4 (&xv)[8], const ModVec& m, bf16_t* hrow, unsigned char* h8row, LAS float* lrow, int lane) {
    float ss = 0.f;
#pragma unroll
    for (int i = 0; i < 8; ++i) ss += xv[i][0] * xv[i][0] + xv[i][1] * xv[i][1] + xv[i][2] * xv[i][2] + xv[i][3] * xv[i][3];
    ss = wave_sum(ss);
    const float rs = 1.0f / sqrtf(ss * (1.0f / D) + EPS);
#pragma unroll
    for (int i = 0; i < 8; ++i) { const int c = i * 256 + lane * 4;
        const f32x4 y = (xv[i] * rs) * m.a[i] + m.b[i];
        if constexpr (WBF) { u32x2 w; w.x = cvt_pk_bf16(y[0], y[1]); w.y = cvt_pk_bf16(y[2], y[3]); *(u32x2*)(hrow + c) = w; }
        if constexpr (W8) *(int*)(h8row + c) = pk4_fp8(y[0] * S8_H, y[1] * S8_H, y[2] * S8_H, y[3] * S8_H);
        if constexpr (TO_LDS) *(LAS f32x4*)(lrow + c) = y; }
}
__device__ __forceinline__ int row_rb(int r) { return r < TX ? (r >> 12) : NB; }

__device__ __forceinline__ const float* xin_row(const Params& P, const unsigned char* ws, int l, int r) {
    return (l == 0) ? ((r < TX) ? P.in[I_X] + (size_t)r * D : P.in[I_CTX] + (size_t)(r - TX) * D) : (const float*)(ws + WS_X2) + (size_t)r * D; }
__device__ __forceinline__ void ph_norm_in(const Params& P, int nrows) {
    unsigned char* const ws = lptr(P.ws);
    const int tid = ltid(), lane = tid & 63, wid = tid >> 6, G = gridDim.x;
    const float* modv = (const float*)(ws + WS_MODV); bf16_t* H = (bf16_t*)(ws + WS_H);
    const int per = (nrows + G - 1) / G, r0 = blockIdx.x * per, r1 = (r0 + per < nrows) ? r0 + per : nrows;
    ModVec mv; int cur = -1;
    for (int r = r0 + wid; r < r1; r += 8) {
        const int rb = row_rb(r);
        if (rb != cur) { const float* m = modv + (size_t)rb * 12288; modvec_load(mv, P.in[I_NORM1], m + 2048, m, lane); cur = rb; }
        const float* xr = (r < TX) ? P.in[I_X] + (size_t)r * D : P.in[I_CTX] + (size_t)(r - TX) * D;
        f32x4 xv[8];
#pragma unroll
        for (int i = 0; i < 8; ++i) xv[i] = *(const f32x4*)(xr + i * 256 + lane * 4);
        norm_mod_store2<false, true, true>(xv, mv, H + (size_t)r * D, (unsigned char*)(ws + WS_H8) + (size_t)r * D, (LAS float*)nullptr, lane);
    }
}

__device__ __forceinline__ float swz_xor1(float v) { return __int_as_float(__builtin_amdgcn_ds_swizzle(__float_as_int(v), 0x041F)); }
__device__ __forceinline__ float swz_xor2(float v) { return __int_as_float(__builtin_amdgcn_ds_swizzle(__float_as_int(v), 0x081F)); }
__device__ __forceinline__ float swz_xor4(float v) { return __int_as_float(__builtin_amdgcn_ds_swizzle(__float_as_int(v), 0x101F)); }
__device__ __forceinline__ void head128_norm_rope(const bf16_t* __restrict__ src, const float* __restrict__ gain, const float* __restrict__ rope, unsigned char* __restrict__ dst, int j, bool do_store) {
    const u32x4 w0 = *(const u32x4*)(src + j * 16), w1 = *(const u32x4*)(src + j * 16 + 8);
    float v[16];
#pragma unroll
    for (int i = 0; i < 4; ++i) { v[2 * i] = BF_LO(w0[i]); v[2 * i + 1] = BF_HI(w0[i]); v[8 + 2 * i] = BF_LO(w1[i]); v[9 + 2 * i] = BF_HI(w1[i]); }
    float ss = 0.f;
#pragma unroll
    for (int i = 0; i < 16; ++i) ss += v[i] * v[i];
    ss += swz_xor1(ss); ss += swz_xor2(ss); ss += swz_xor4(ss);
    const float rs = 1.0f / sqrtf(ss * (1.0f / 128.0f) + EPS);
#pragma unroll
    for (int q = 0; q < 4; ++q) { const f32x4 g = *(const f32x4*)(gain + j * 16 + q * 4);
#pragma unroll
        for (int i = 0; i < 4; ++i) v[q * 4 + i] *= rs * g[i]; }
    if (rope) { const int idx0 = (j & 3) * 16; const bool first = j < 4;
#pragma unroll
        for (int q = 0; q < 4; ++q) { const f32x4 cs = *(const f32x4*)(rope + idx0 + q * 4), sn = *(const f32x4*)(rope + 64 + idx0 + q * 4);
#pragma unroll
            for (int i = 0; i < 4; ++i) { const float y = v[q * 4 + i], yp = swz_xor4(y); v[q * 4 + i] = first ? (y * cs[i] - yp * sn[i]) : (y * cs[i] + yp * sn[i]); } } }
    if (do_store) { u32x4 o;
#pragma unroll
        for (int i = 0; i < 4; ++i) o[i] = (unsigned)pk4_fp8(v[4 * i] * S8_QK, v[4 * i + 1] * S8_QK, v[4 * i + 2] * S8_QK, v[4 * i + 3] * S8_QK);
        *(u32x4*)(dst + j * 16) = o; }
}
__device__ __forceinline__ void vt_tiles(const bf16_t* src, int ld, int colbase, int colstride, int nh, unsigned char* dst, LAS unsigned char* lds) {
    const int tid = ltid(), G = gridDim.x, per = nh * (LKV / 64);
    for (int t = blockIdx.x; t < NB * per; t += G) {
        const int b = t / per, rem = t % per, h = rem / (LKV / 64), key0 = (rem % (LKV / 64)) * 64;
        const int row0 = (key0 < CL) ? TX + b * CL + key0 : b * SEQ + key0 - CL;
        { const int key = tid >> 3, dch = (tid & 7) * 16; const bf16_t* p = src + (size_t)(row0 + key) * ld + colbase + h * colstride + dch;
          const u32x4 w0 = *(const u32x4*)p, w1 = *(const u32x4*)(p + 8); u32x4 o;
          o.x = (unsigned)pk4_fp8(BF_LO(w0.x) * S8_V, BF_HI(w0.x) * S8_V, BF_LO(w0.y) * S8_V, BF_HI(w0.y) * S8_V); o.y = (unsigned)pk4_fp8(BF_LO(w0.z) * S8_V, BF_HI(w0.z) * S8_V, BF_LO(w0.w) * S8_V, BF_HI(w0.w) * S8_V);
          o.z = (unsigned)pk4_fp8(BF_LO(w1.x) * S8_V, BF_HI(w1.x) * S8_V, BF_LO(w1.y) * S8_V, BF_HI(w1.y) * S8_V); o.w = (unsigned)pk4_fp8(BF_LO(w1.z) * S8_V, BF_HI(w1.z) * S8_V, BF_LO(w1.w) * S8_V, BF_HI(w1.w) * S8_V);
          *(LAS u32x4*)(lds + key * 144 + dch) = o; }
        __syncthreads();
        { const int d = tid >> 2, kc = (tid & 3) * 16; u32x4 o;
#pragma unroll
          for (int q = 0; q < 4; ++q) { unsigned w = 0;
#pragma unroll
              for (int i = 0; i < 4; ++i) w |= (unsigned)lds[(kc + q * 4 + i) * 144 + d] << (8 * i);
              o[q] = w; }
          *(u32x4*)(dst + ((size_t)(b * nh + h) * 128 + d) * LKV + key0 + kc) = o; }
        __syncthreads();
    }
}
__device__ __forceinline__ void head128_core(const u32x4 w0, const u32x4 w1, const f32x4 (&g)[4], const f32x4 (&cs)[4], const f32x4 (&sn)[4], bool use_rope, int j, float (&v)[16]) {
#pragma unroll
    for (int i = 0; i < 4; ++i) { v[2 * i] = BF_LO(w0[i]); v[2 * i + 1] = BF_HI(w0[i]); v[8 + 2 * i] = BF_LO(w1[i]); v[9 + 2 * i] = BF_HI(w1[i]); }
    float ss = 0.f;
#pragma unroll
    for (int i = 0; i < 16; ++i) ss += v[i] * v[i];
    ss += swz_xor1(ss); ss += swz_xor2(ss); ss += swz_xor4(ss);
    const float rs = 1.0f / sqrtf(ss * (1.0f / 128.0f) + EPS);
#pragma unroll
    for (int q = 0; q < 4; ++q)
#pragma unroll
        for (int i = 0; i < 4; ++i) v[q * 4 + i] *= rs * g[q][i];
    const bool first = j < 4;
#pragma unroll
    for (int q = 0; q < 4; ++q)
#pragma unroll
        for (int i = 0; i < 4; ++i) { const float y = v[q * 4 + i], yp = swz_xor4(y); const float ro = first ? (y * cs[q][i] - yp * sn[q][i]) : (y * cs[q][i] + yp * sn[q][i]); v[q * 4 + i] = use_rope ? ro : y; }
}
__device__ __forceinline__ void post_in_row(const bf16_t* __restrict__ pr, unsigned char* __restrict__ KA, unsigned char* __restrict__ QA, unsigned char* __restrict__ CKVN, unsigned char* __restrict__ CQN,
                                            bf16_t* __restrict__ YB, const float* __restrict__ ropeA, const float* __restrict__ gk, const float* __restrict__ gq, const float* __restrict__ gkv,
                                            const float* __restrict__ gcq, const float (&cwr)[2][3][8], int r, int Mq, int lane) {
    const bool isx = r < TX; const int b = isx ? (r >> 12) : ((r - TX) >> 8); const int s = isx ? (r & (SEQ - 1)) : ((r - TX) & (CL - 1));
    const int key = isx ? CL + s : s, qrow = isx ? s : SEQ + s;
    const int j = lane & 7, hk = (lane >> 3) & 1, hq = lane >> 3;
    const int slen = isx ? SEQ : CL; const bool hasp = s > 0, hasn = s < slen - 1;
    const u32x4 k0 = *(const u32x4*)(pr + C_K + hk * 128 + j * 16), k1 = *(const u32x4*)(pr + C_K + hk * 128 + j * 16 + 8);
    const u32x4 q0 = *(const u32x4*)(pr + C_Q + hq * 128 + j * 16), q1 = *(const u32x4*)(pr + C_Q + hq * 128 + j * 16 + 8);
    const u32x2 wkv = *(const u32x2*)(pr + C_CKV + lane * 4);
    const u32x4 wcq = *(const u32x4*)(pr + C_CQ + lane * 8);
    u32x4 xc[2], gc[2], gb[2], xp[2], gp[2], xn[2], gn[2];
#define PI_CONV_LOAD(p) do { const int c_ = (p) * 512 + lane * 8; \
        xc[p] = *(const u32x4*)(pr + C_XB + c_); gc[p] = *(const u32x4*)(pr + C_GC + c_); gb[p] = *(const u32x4*)(pr + C_GB + c_); \
        xp[p] = *(const u32x4*)(pr - INCP + C_XB + c_); gp[p] = *(const u32x4*)(pr - INCP + C_GC + c_); \
        xn[p] = *(const u32x4*)(pr + INCP + C_XB + c_); gn[p] = *(const u32x4*)(pr + INCP + C_GC + c_); } while (0)
    PI_CONV_LOAD(0);
    const float* rope = ropeA + (size_t)(isx ? s : 0) * 128 + (j & 3) * 16;
    f32x4 cs[4], sn[4], gkr[4], gqr[4];
#pragma unroll
    for (int q = 0; q < 4; ++q) { cs[q] = *(const f32x4*)(rope + q * 4); sn[q] = *(const f32x4*)(rope + 64 + q * 4); gkr[q] = *(const f32x4*)(gk + j * 16 + q * 4); gqr[q] = *(const f32x4*)(gq + j * 16 + q * 4); }
    const f32x4 gkv4 = *(const f32x4*)(gkv + lane * 4), gc0 = *(const f32x4*)(gcq + lane * 8), gc1 = *(const f32x4*)(gcq + lane * 8 + 4);
    __builtin_amdgcn_sched_barrier(0);
    { float v[16]; head128_core(k0, k1, gkr, cs, sn, isx, j, v);
      if (lane < 16) { u32x4 o;
#pragma unroll
          for (int i = 0; i < 4; ++i) o[i] = (unsigned)pk4_fp8(v[4 * i] * S8_QK, v[4 * i + 1] * S8_QK, v[4 * i + 2] * S8_QK, v[4 * i + 3] * S8_QK);
          *(u32x4*)(KA + ((size_t)(b * 2 + hk) * LKV + key) * 128 + j * 16) = o; } }
    { const float v0 = BF_LO(wkv.x), v1 = BF_HI(wkv.x), v2 = BF_LO(wkv.y), v3 = BF_HI(wkv.y);
      const float ss = wave_sum(v0 * v0 + v1 * v1 + v2 * v2 + v3 * v3); const float rs = 1.0f / sqrtf(ss * (1.0f / 256.0f) + EPS);
      *(int*)(CKVN + (size_t)r * 256 + lane * 4) = pk4_fp8(v0 * rs * gkv4[0] * S8_H, v1 * rs * gkv4[1] * S8_H, v2 * rs * gkv4[2] * S8_H, v3 * rs * gkv4[3] * S8_H); }
    __builtin_amdgcn_sched_barrier(0);
    PI_CONV_LOAD(1);
#undef PI_CONV_LOAD
    __builtin_amdgcn_sched_barrier(0);
    if (r < Mq) {
        { float v[16]; head128_core(q0, q1, gqr, cs, sn, isx, j, v); u32x4 o;
#pragma unroll
          for (int i = 0; i < 4; ++i) o[i] = (unsigned)pk4_fp8(v[4 * i] * S8_QK, v[4 * i + 1] * S8_QK, v[4 * i + 2] * S8_QK, v[4 * i + 3] * S8_QK);
          *(u32x4*)(QA + ((size_t)(b * 8 + hq) * LKV + qrow) * 128 + j * 16) = o; }
        { float v[8];
#pragma unroll
          for (int i = 0; i < 4; ++i) { v[2 * i] = BF_LO(wcq[i]); v[2 * i + 1] = BF_HI(wcq[i]); }
          float ss = 0.f;
#pragma unroll
          for (int i = 0; i < 8; ++i) ss += v[i] * v[i];
          ss = wave_sum(ss); const float rs = 1.0f / sqrtf(ss * (1.0f / 512.0f) + EPS);
          u32x2 o; o.x = (unsigned)pk4_fp8(v[0] * rs * gc0[0] * S8_H, v[1] * rs * gc0[1] * S8_H, v[2] * rs * gc0[2] * S8_H, v[3] * rs * gc0[3] * S8_H);
          o.y = (unsigned)pk4_fp8(v[4] * rs * gc1[0] * S8_H, v[5] * rs * gc1[1] * S8_H, v[6] * rs * gc1[2] * S8_H, v[7] * rs * gc1[3] * S8_H);
          *(u32x2*)(CQN + (size_t)r * 512 + lane * 8) = o; }
#pragma unroll
        for (int p = 0; p < 2; ++p) { const int c = p * 512 + lane * 8;
            if (!hasp) { xp[p] = (u32x4){0u, 0u, 0u, 0u}; gp[p] = xp[p]; }
            if (!hasn) { xn[p] = (u32x4){0u, 0u, 0u, 0u}; gn[p] = xn[p]; }
            float o[8];
#pragma unroll
            for (int i = 0; i < 8; ++i) {
#define BFH(W, J) __uint_as_float(((J) & 1) ? ((W)[(J) >> 1] & 0xffff0000u) : ((W)[(J) >> 1] << 16))
                const float zc = BFH(xc[p], i) * BFH(gc[p], i), zp = BFH(xp[p], i) * BFH(gp[p], i), zn = BFH(xn[p], i) * BFH(gn[p], i);
                o[i] = BFH(gb[p], i) * (cwr[p][0][i] * zp + cwr[p][1][i] * zc + cwr[p][2][i] * zn); }
#undef BFH
            u32x4 w; w.x = cvt_pk_bf16(o[0], o[1]); w.y = cvt_pk_bf16(o[2], o[3]); w.z = cvt_pk_bf16(o[4], o[5]); w.w = cvt_pk_bf16(o[6], o[7]);
            *(u32x4*)(YB + (size_t)r * 1024 + c) = w; }
    }
}
__device__ __forceinline__ void ph_post_in(const Params& P, int l, int Mq, LAS unsigned char* lds) {
    unsigned char* const ws = lptr(P.ws);
    const int tid = ltid(), lane = tid & 63, wid = tid >> 6, G = gridDim.x;
    const bf16_t* Pb = (const bf16_t*)(ws + WS_P);
    unsigned char* KA = (unsigned char*)(ws + WS_KA); unsigned char* QA = (unsigned char*)(ws + WS_QA);
    unsigned char* CKVN = (unsigned char*)(ws + WS_CKVN); unsigned char* CQN = (unsigned char*)(ws + WS_CQN); bf16_t* YB = (bf16_t*)(ws + WS_YCAT) + (size_t)MT * 1024;
    const float* ropeA = (const float*)(ws + WS_ROPEA);
    const float* gk = P.in[I_GKN] + l * 128; const float* gq = P.in[I_GQN] + l * 128;
    const float* gkv = P.in[I_MKVLN] + l * 256; const float* gcq = P.in[I_MQLN] + l * 512; const float* cw = P.in[I_CONVW] + (size_t)l * 3 * 1024;
    float cwr[2][3][8];
#pragma unroll
    for (int p = 0; p < 2; ++p)
#pragma unroll
        for (int q = 0; q < 3; ++q) { const f32x4 a = *(const f32x4*)(cw + q * 1024 + p * 512 + lane * 8), b2 = *(const f32x4*)(cw + q * 1024 + p * 512 + lane * 8 + 4);
#pragma unroll
            for (int j = 0; j < 4; ++j) { cwr[p][q][j] = a[j]; cwr[p][q][4 + j] = b2[j]; } }
    const int per = (MT + G - 1) / G, rb0 = blockIdx.x * per, rb1 = (rb0 + per < MT) ? rb0 + per : MT;
    for (int r = rb0 + wid; r < rb1; r += 8) post_in_row(Pb + (size_t)r * INCP, KA, QA, CKVN, CQN, YB, ropeA, gk, gq, gkv, gcq, cwr, r, Mq, lane);
    vt_tiles(Pb + C_V, INCP, 0, 128, 2, (unsigned char*)(ws + WS_VA), lds);
}

__device__ __forceinline__ void mla192_norm_rope(const bf16_t* nope, const bf16_t* ropesrc, const float* gain, const float* rope  , unsigned char* dst, int j) {
    const u32x4 w0 = *(const u32x4*)(nope + j * 16), w1 = *(const u32x4*)(nope + j * 16 + 8), w2 = *(const u32x4*)(ropesrc + j * 8);
    float v[16], t[8];
#pragma unroll
    for (int i = 0; i < 4; ++i) { v[2 * i] = BF_LO(w0[i]); v[2 * i + 1] = BF_HI(w0[i]); v[8 + 2 * i] = BF_LO(w1[i]); v[9 + 2 * i] = BF_HI(w1[i]); t[2 * i] = BF_LO(w2[i]); t[2 * i + 1] = BF_HI(w2[i]); }
    float ss = 0.f;
#pragma unroll
    for (int i = 0; i < 16; ++i) ss += v[i] * v[i];
#pragma unroll
    for (int i = 0; i < 8; ++i) ss += t[i] * t[i];
    ss += swz_xor1(ss); ss += swz_xor2(ss); ss += swz_xor4(ss);
    const float rs = 1.0f / sqrtf(ss * (1.0f / 192.0f) + EPS);
#pragma unroll
    for (int q = 0; q < 4; ++q) { const f32x4 g = *(const f32x4*)(gain + j * 16 + q * 4);
#pragma unroll
        for (int i = 0; i < 4; ++i) v[q * 4 + i] *= rs * g[i]; }
#pragma unroll
    for (int q = 0; q < 2; ++q) { const f32x4 g = *(const f32x4*)(gain + 128 + j * 8 + q * 4);
#pragma unroll
        for (int i = 0; i < 4; ++i) t[q * 4 + i] *= rs * g[i]; }
    if (rope) { const int idx0 = (j & 3) * 8; const bool first = j < 4;
#pragma unroll
        for (int q = 0; q < 2; ++q) { const f32x4 cs = *(const f32x4*)(rope + idx0 + q * 4), sn = *(const f32x4*)(rope + 32 + idx0 + q * 4);
#pragma unroll
            for (int i = 0; i < 4; ++i) { const float y = t[q * 4 + i], yp = swz_xor4(y); t[q * 4 + i] = first ? (y * cs[i] - yp * sn[i]) : (y * cs[i] + yp * sn[i]); } } }
    u32x4 o; u32x2 o2;
#pragma unroll
    for (int i = 0; i < 4; ++i) o[i] = (unsigned)pk4_fp8(v[4 * i] * S8_QK, v[4 * i + 1] * S8_QK, v[4 * i + 2] * S8_QK, v[4 * i + 3] * S8_QK);
    o2.x = (unsigned)pk4_fp8(t[0] * S8_QK, t[1] * S8_QK, t[2] * S8_QK, t[3] * S8_QK); o2.y = (unsigned)pk4_fp8(t[4] * S8_QK, t[5] * S8_QK, t[6] * S8_QK, t[7] * S8_QK);
    *(u32x4*)(dst + j * 16) = o; *(u32x2*)(dst + 128 + j * 8) = o2;
}
__device__ __forceinline__ void ph_post_up(const Params& P, int l, int Mq, LAS unsigned char* lds) {
    unsigned char* const ws = lptr(P.ws);
    const int tid = ltid(), lane = tid & 63, wid = tid >> 6, G = gridDim.x, hh = lane >> 3, j = lane & 7;
    const bf16_t* Pb = (const bf16_t*)(ws + WS_P); const bf16_t* KVUP = (const bf16_t*)(ws + WS_KVUP); const bf16_t* QUP = (const bf16_t*)(ws + WS_QUP);
    unsigned char* KC = (unsigned char*)(ws + WS_KC); unsigned char* QC = (unsigned char*)(ws + WS_QC);
    const float* ropeC = (const float*)(ws + WS_ROPEC);
    const float* gk = P.in[I_MKN] + l * 192; const float* gq = P.in[I_MQN] + l * 192;
    const int per = (MT + G - 1) / G, rb0 = blockIdx.x * per, rb1 = (rb0 + per < MT) ? rb0 + per : MT;
    for (int r = rb0 + wid; r < rb1; r += 8) {
        const bool isx = r < TX; const int b = isx ? (r >> 12) : ((r - TX) >> 8); const int s_ = isx ? (r & (SEQ - 1)) : ((r - TX) & (CL - 1));
        const int key = isx ? CL + s_ : s_, qrow = isx ? s_ : SEQ + s_;
        const float* rope = isx ? ropeC + (size_t)s_ * 64 : nullptr;
        const bf16_t* kvr = KVUP + (size_t)r * 2048 + hh * 256; const bf16_t* krp = Pb + (size_t)r * INCP + C_KR;
        mla192_norm_rope(kvr, krp, gk, rope, KC + ((size_t)(b * 8 + hh) * LKV + key) * 192, j);
        if (r < Mq) { const bf16_t* qr = QUP + (size_t)r * 1536 + hh * 192;
            mla192_norm_rope(qr, qr + 128, gq, rope, QC + ((size_t)(b * 8 + hh) * LKV + qrow) * 192, j); }
    }
    vt_tiles(KVUP + 128, 2048, 0, 256, 8, (unsigned char*)(ws + WS_VC), lds);
}

__device__ __forceinline__ void ph_attention(const Params& P, int l, char* lds_g, int vcu) {
    unsigned char* const ws = lptr(P.ws);
    const unsigned char* KA = (const unsigned char*)(ws + WS_KA); const unsigned char* VA = (const unsigned char*)(ws + WS_VA); const unsigned char* QA = (const unsigned char*)(ws + WS_QA);
    const unsigned char* KC = (const unsigned char*)(ws + WS_KC); const unsigned char* QC = (const unsigned char*)(ws + WS_QC); const unsigned char* VC = (const unsigned char*)(ws + WS_VC);
    unsigned char* YA = (unsigned char*)(ws + WS_YCAT); unsigned char* YC = YA + (size_t)2 * MT * 1024 * 2;
    const int G = gridDim.x, nun = (l == 0) ? 544 : 512;
#ifndef NO_GQA
#ifndef MK_DUP_GQA
#define MK_DUP_GQA 0
#endif
#pragma unroll 1
    for (int rep2 = 0; rep2 <= MK_DUP_GQA; ++rep2)
#pragma unroll 1
    for (int u = vcu; u < nun; u += G) {
        int b, h, qrow0, orow0, seq;
        if (u < 512) { const int gi = u >> 6; b = gi >> 1; h = (gi & 1) * 4 + ((u >> 4) & 3); const int qb = u & 15; qrow0 = qb * 256; orow0 = b * SEQ + qb * 256; seq = LKV; }
        else { const int bh = u - 512; b = bh >> 3; h = bh & 7; qrow0 = SEQ; orow0 = TX + b * CL; seq = CL; }
        const int kvh = h >> 2;
        att::attn_dense_body<128, 2>(QA + ((size_t)(b * 8 + h) * LKV + qrow0) * 128, KA + (size_t)(b * 2 + kvh) * LKV * 128, VA + (size_t)(b * 2 + kvh) * 128 * LKV, LKV,
                                     YA + (size_t)orow0 * 1024 + h * 128, seq, lds_g);
    }
#endif
#ifndef NO_MLA
#ifndef MK_DUP_MLA
#define MK_DUP_MLA 0
#endif
#pragma unroll 1
    for (int rep2 = 0; rep2 <= MK_DUP_MLA; ++rep2)
#pragma unroll 1
    for (int u = vcu; u < nun; u += G) {
        int bh, qrow0, orow0, seq;
        if (u < 512) { bh = u >> 4; const int qb = u & 15; qrow0 = qb * 256; orow0 = (bh >> 3) * SEQ + qb * 256; seq = LKV; }
        else { bh = u - 512; qrow0 = SEQ; orow0 = TX + (bh >> 3) * CL; seq = CL; }
        att::attn_dense_body<192, 1>(QC + ((size_t)bh * LKV + qrow0) * 192, KC + (size_t)bh * LKV * 192, VC + (size_t)bh * 128 * LKV, LKV,
                                     YC + (size_t)orow0 * 1024 + (bh & 7) * 128, seq, lds_g);
    }
#endif
}

__device__ __forceinline__ void ph_norm_route(const Params& P, int l, int Mq, LAS unsigned char* lds, bool dry = false) {
    unsigned char* const ws = lptr(P.ws);
    const int tid = ltid(), lane = tid & 63, wid = tid >> 6, G = gridDim.x;
    constexpr int HSP = D + 4;
    LAS float* hs = (LAS float*)lds; LAS float* part = (LAS float*)(lds + 66048); LAS int* lcnt = (LAS int*)(lds + 66048 + 16384); LAS int* lbase = lcnt + 32; LAS int* ent = lbase + 32;
    const float* modv = (const float*)(ws + WS_MODV) + (size_t)l * 5 * 12288; const bf16_t* X1 = (const bf16_t*)(ws + WS_X1); bf16_t* H = (bf16_t*)(ws + WS_H);
    int* rte = (int*)(ws + WS_RTE); int* rtp = (int*)(ws + WS_RTP); float* rtw = (float*)(ws + WS_RTW);
    unsigned* gcnt = (unsigned*)(ws + WS_CTL) + CW_CNT + l * 32;
    if (tid < 32) lcnt[tid] = 0;
    __syncthreads();
    int nent = 0;
    const int per = (Mq + G - 1) / G, rbase = blockIdx.x * per, rend = (rbase + per < Mq) ? rbase + per : Mq;
    ModVec mvec; int cur_rb = -1;
    const float lbias = (lane < 32) ? P.in[I_BROUTER][l * 32 + lane] : ((lane < 36) ? P.in[I_BGROUP][l * 4 + (lane - 32)] : 0.f);
    u32x2 raw[8];
    if (rbase + wid < rend) { const bf16_t* xr = X1 + (size_t)(rbase + wid) * D;
#pragma unroll
        for (int i = 0; i < 8; ++i) raw[i] = *(const u32x2*)(xr + i * 256 + lane * 4); }
    for (int r8 = rbase; r8 < rend; r8 += 8) {
        const int r = r8 + wid; const bool valid = r < rend;
        if (valid) { const int rb = row_rb(r);
          if (rb != cur_rb) { const float* m = modv + (size_t)rb * 12288; modvec_load(mvec, P.in[I_NORM2] + l * D, m + 8192, m + 6144, lane); cur_rb = rb; }
          f32x4 xv[8];
#pragma unroll
          for (int i = 0; i < 8; ++i) { const u32x2 w = raw[i]; xv[i] = (f32x4){BF_LO(w.x), BF_HI(w.x), BF_LO(w.y), BF_HI(w.y)}; }
          norm_mod_store2<true, false, true>(xv, mvec, H, (unsigned char*)(ws + WS_H8) + (size_t)r * D, hs + wid * HSP, lane); }
        __syncthreads();
        {
            const int kq = lane >> 4;
            f32x4 a3[3];
#pragma unroll
            for (int nt = 0; nt < 3; ++nt) a3[nt] = (f32x4){0.f, 0.f, 0.f, 0.f};
            const LAS float* hp = hs + (lane & 7) * HSP + wid * 256 + 8 * kq;
            const u32x4* wb = (const u32x4*)(ws + WS_WR) + (size_t)(l * 64 + wid * 8) * 3 * 2 * 64 + lane;
#pragma unroll 2
            for (int ks = 0; ks < 8; ++ks) {
                const f32x4 x0 = *(const LAS f32x4*)(hp + ks * 32), x1 = *(const LAS f32x4*)(hp + ks * 32 + 4);
                u32x4 bh[3], bl[3];
#pragma unroll
                for (int nt = 0; nt < 3; ++nt) { bh[nt] = wb[((ks * 3 + nt) * 2) * 64]; bl[nt] = wb[((ks * 3 + nt) * 2 + 1) * 64]; }
                u32x4 ah, al;
                ah.x = cvt_pk_bf16(x0[0], x0[1]); ah.y = cvt_pk_bf16(x0[2], x0[3]); ah.z = cvt_pk_bf16(x1[0], x1[1]); ah.w = cvt_pk_bf16(x1[2], x1[3]);
                al.x = cvt_pk_bf16(x0[0] - BF_LO(ah.x), x0[1] - BF_HI(ah.x)); al.y = cvt_pk_bf16(x0[2] - BF_LO(ah.y), x0[3] - BF_HI(ah.y));
                al.z = cvt_pk_bf16(x1[0] - BF_LO(ah.z), x1[1] - BF_HI(ah.z)); al.w = cvt_pk_bf16(x1[2] - BF_LO(ah.w), x1[3] - BF_HI(ah.w));
                const bf16x8 Ah = *reinterpret_cast<const bf16x8*>(&ah), Al = *reinterpret_cast<const bf16x8*>(&al);
#pragma unroll
                for (int nt = 0; nt < 3; ++nt) { const bf16x8 Bh = *reinterpret_cast<const bf16x8*>(&bh[nt]), Bl = *reinterpret_cast<const bf16x8*>(&bl[nt]);
                    a3[nt] = __builtin_amdgcn_mfma_f32_16x16x32_bf16(Al, Bh, a3[nt], 0, 0, 0);
                    a3[nt] = __builtin_amdgcn_mfma_f32_16x16x32_bf16(Ah, Bl, a3[nt], 0, 0, 0);
                    a3[nt] = __builtin_amdgcn_mfma_f32_16x16x32_bf16(Ah, Bh, a3[nt], 0, 0, 0); }
            }
            __builtin_amdgcn_sched_barrier(0);
            if (r + 8 < rend) { const bf16_t* xr = X1 + (size_t)(r + 8) * D;
#pragma unroll
                for (int i = 0; i < 8; ++i) raw[i] = *(const u32x2*)(xr + i * 256 + lane * 4); }
            __builtin_amdgcn_sched_barrier(0);
            if (kq < 2) {
#pragma unroll
                for (int nt = 0; nt < 3; ++nt)
#pragma unroll
                    for (int i = 0; i < 4; ++i) part[(wid * 8 + 4 * kq + i) * 64 + nt * 16 + (lane & 15)] = a3[nt][i]; }
        }
        __syncthreads();
        float lg = 0.f;
#pragma unroll
        for (int w = 0; w < 8; ++w) lg += part[(w * 8 + wid) * 64 + lane];
        lg += lbias;
        const float g0 = rdlane(lg, 32), g1 = rdlane(lg, 33), g2 = rdlane(lg, 34), g3 = rdlane(lg, 35);
        int gi = 0; float gb = g0; if (g1 > gb) { gb = g1; gi = 1; } if (g2 > gb) { gb = g2; gi = 2; } if (g3 > gb) { gb = g3; gi = 3; }
        const float gprob = 1.0f / (expf(g0 - gb) + expf(g1 - gb) + expf(g2 - gb) + expf(g3 - gb));
        float ev[8];
#pragma unroll
        for (int j = 0; j < 8; ++j) ev[j] = rdlane(lg, gi * 8 + j);
        int i0 = 0; float v0 = ev[0];
#pragma unroll
        for (int j = 1; j < 8; ++j) if (ev[j] > v0) { v0 = ev[j]; i0 = j; }
        int i1 = -1; float v1 = -3.0e38f;
#pragma unroll
        for (int j = 0; j < 8; ++j) if (j != i0 && ev[j] > v1) { v1 = ev[j]; i1 = j; }
        const float e1 = expf(v1 - v0), c0 = 1.0f / (1.0f + e1), c1 = e1 * c0;
        const int ex0 = gi * 8 + i0, ex1 = gi * 8 + i1;
        if (lane == 0 && !valid) { LAS int* en = ent + (nent + wid * 2) * 4; en[0] = -1; en[4] = -1; }
        if (lane == 0 && !dry && valid) {
            const int p0 = __hip_atomic_fetch_add(lcnt + ex0, 1, __ATOMIC_RELAXED, __HIP_MEMORY_SCOPE_WORKGROUP);
            const int p1 = __hip_atomic_fetch_add(lcnt + ex1, 1, __ATOMIC_RELAXED, __HIP_MEMORY_SCOPE_WORKGROUP);
            rte[r * 2] = ex0; rte[r * 2 + 1] = ex1; rtw[r * 2] = c0 * gprob; rtw[r * 2 + 1] = c1 * gprob;
            LAS int* en = ent + (nent + wid * 2) * 4; en[0] = r * 2; en[1] = ex0; en[2] = p0; en[4] = r * 2 + 1; en[5] = ex1; en[6] = p1;
        }
        nent += 16;
        __syncthreads();
    }
    if (dry) return;
    if (tid < 32) lbase[tid] = (int)__hip_atomic_fetch_add(gcnt + tid, (unsigned)lcnt[tid], __ATOMIC_RELAXED, __HIP_MEMORY_SCOPE_AGENT);
    __syncthreads();
    int* elist = (int*)(ws + WS_ELIST);
    for (int i = tid; i < nent; i += 512) { const LAS int* en = ent + i * 4; if (en[0] < 0) continue; const int pos = lbase[en[1]] + en[2]; rtp[en[0]] = pos; elist[(size_t)en[1] * MT + pos] = en[0] >> 1; }
    __syncthreads();
}

__device__ __forceinline__ void moe_tables(const Params& P, int l, LAS unsigned char* lds) {
    unsigned char* const ws = lptr(P.ws);
    const int tid = ltid();
    LAS int* nblk = (LAS int*)(lds + LDS_STAGE + MISC_NBLK); LAS int* blke = (LAS int*)(lds + LDS_STAGE + MISC_BLKE);
    LAS int* fblk = (LAS int*)(lds + LDS_STAGE + MISC_FBLK); LAS int* ecnt = (LAS int*)(lds + LDS_STAGE + MISC_ECNT);
    const unsigned* gcnt = (const unsigned*)(ws + WS_CTL) + CW_CNT + l * 32;
    LAS int* tmpb = (LAS int*)(lds + LDS_STAGE + MISC_TMPB);
    if (tid < NE) { const int c = (int)__hip_atomic_load(gcnt + tid, __ATOMIC_RELAXED, __HIP_MEMORY_SCOPE_AGENT); ecnt[tid] = c; tmpb[tid] = (c + 255) >> 8; }
    __syncthreads();
    if (tid < NE) {
        int pre = 0;
#pragma unroll 1
        for (int e = 0; e < tid; ++e) pre += tmpb[e];
        const int k = tmpb[tid];
        fblk[tid] = pre;
#pragma unroll 1
        for (int q = 0; q < k; ++q) if (pre + q < MAXBLK) blke[pre + q] = tid;
        if (tid == NE - 1) nblk[0] = (pre + k < MAXBLK) ? pre + k : MAXBLK; }
    __syncthreads();
}
__device__ __forceinline__ void ph_gather(const Params& P, int l, int Mq, LAS unsigned char* lds) {
    unsigned char* const ws = lptr(P.ws);
    const int tid = ltid(), lane = tid & 63, wid = tid >> 6, G = gridDim.x;
    LAS int* pstart = (LAS int*)lds;
    const unsigned* gcnt = (const unsigned*)(ws + WS_CTL) + CW_CNT + l * 32;
    if (tid == 0) { int acc = 0; for (int e = 0; e < NE; ++e) { pstart[e] = acc; const int c = (int)__hip_atomic_load(gcnt + e, __ATOMIC_RELAXED, __HIP_MEMORY_SCOPE_AGENT); acc += ((c + 255) >> 8) << 8; } }
    __syncthreads();
    const int* rte = (const int*)(ws + WS_RTE); const int* rtp = (const int*)(ws + WS_RTP); int* rts = (int*)(ws + WS_RTS);
    const bf16_t* H = (const bf16_t*)(ws + WS_H); bf16_t* XS = (bf16_t*)(ws + WS_XS);
    for (int a = blockIdx.x * 8 + wid; a < Mq * 2; a += G * 8) {
        const int r = a >> 1; int slot = pstart[rte[a]] + rtp[a]; if (slot >= MAXSLOT) slot = MAXSLOT - 1;
        if (lane == 0) rts[a] = slot;
        const u32x4* src = (const u32x4*)(H + (size_t)r * D); u32x4* dst = (u32x4*)(XS + (size_t)slot * D);
#pragma unroll
        for (int i = 0; i < 4; ++i) dst[i * 64 + lane] = src[i * 64 + lane];
    }
    __syncthreads();
}

__device__ __forceinline__ void ph_combine(const Params& P, int l, int Mq, LAS unsigned char* lds) {
    unsigned char* const ws = lptr(P.ws);
    const int tid = ltid(), lane = tid & 63, wid = tid >> 6, G = gridDim.x;
    moe_tables(P, l, lds);
    const LAS int* fblk = (const LAS int*)(lds + LDS_STAGE + MISC_FBLK); const int* rte = (const int*)(ws + WS_RTE); const int* rtp = (const int*)(ws + WS_RTP);
    const float* modv = (const float*)(ws + WS_MODV); const bf16_t* X1 = (const bf16_t*)(ws + WS_X1); bf16_t* X2 = (bf16_t*)(ws + WS_X2); bf16_t* H = (bf16_t*)(ws + WS_H);
    const float* rtw = (const float*)(ws + WS_RTW); const bf16_t* YS = (const bf16_t*)(ws + WS_YS);
    const bool last = (l == 1);
    const int per = (Mq + G - 1) / G, r0 = blockIdx.x * per, r1 = (r0 + per < Mq) ? r0 + per : Mq;
    ModVec mnext; f32x4 g2v[8]; int cur = -1;
    for (int r = r0 + wid; r < r1; r += 8) {
        const int rb = row_rb(r);
        if (rb != cur) { const float* g2 = modv + ((size_t)l * 5 + rb) * 12288 + 10240;
#pragma unroll
            for (int i = 0; i < 8; ++i) g2v[i] = *(const f32x4*)(g2 + i * 256 + lane * 4);
            if (!last) { const float* m = modv + ((size_t)(l + 1) * 5 + rb) * 12288; modvec_load(mnext, P.in[I_NORM1] + (l + 1) * D, m + 2048, m, lane); }
            cur = rb; }
        const int s0 = fblk[rte[r * 2]] * 256 + rtp[r * 2], s1 = fblk[rte[r * 2 + 1]] * 256 + rtp[r * 2 + 1]; const float w0 = rtw[r * 2], w1 = rtw[r * 2 + 1];
        const bf16_t* xr = X1 + (size_t)r * D; const bf16_t* y0 = YS + (size_t)s0 * D; const bf16_t* y1 = YS + (size_t)s1 * D;
        f32x4 xv[8];
#pragma unroll
        for (int i = 0; i < 8; ++i) { const int c = i * 256 + lane * 4; const u32x2 xw = *(const u32x2*)(xr + c); const f32x4 x = (f32x4){BF_LO(xw.x), BF_HI(xw.x), BF_LO(xw.y), BF_HI(xw.y)};
            const u32x2 a = *(const u32x2*)(y0 + c), bq = *(const u32x2*)(y1 + c);
            f32x4 m; m[0] = w0 * __uint_as_float(a.x << 16) + w1 * __uint_as_float(bq.x << 16); m[1] = w0 * __uint_as_float(a.x & 0xffff0000u) + w1 * __uint_as_float(bq.x & 0xffff0000u);
            m[2] = w0 * __uint_as_float(a.y << 16) + w1 * __uint_as_float(bq.y << 16); m[3] = w0 * __uint_as_float(a.y & 0xffff0000u) + w1 * __uint_as_float(bq.y & 0xffff0000u);
            xv[i] = x + g2v[i] * m; }
        if (last) {
#pragma unroll
            for (int i = 0; i < 8; ++i) __builtin_nontemporal_store(xv[i], (f32x4*)(P.out + (size_t)r * D + i * 256 + lane * 4));
        } else {
#pragma unroll
            for (int i = 0; i < 8; ++i) { u32x2 w; w.x = cvt_pk_bf16(xv[i][0], xv[i][1]); w.y = cvt_pk_bf16(xv[i][2], xv[i][3]); *(u32x2*)(X2 + (size_t)r * D + i * 256 + lane * 4) = w; }
            norm_mod_store2<false, true, true>(xv, mnext, H + (size_t)r * D, (unsigned char*)(ws + WS_H8) + (size_t)r * D, (LAS float*)nullptr, lane);
        }
    }
}

constexpr int CVT_A1 = 0, CVT_A1_TOTAL = 200 * CVT_A1, CVT_A6 = 26;
constexpr int NPH = 27;
__global__ void __launch_bounds__(512, 2) mk_fwd(Params P) {
    extern __shared__ __attribute__((aligned(16))) unsigned char shm[];
    LAS unsigned char* lds = (LAS unsigned char*)shm;
    const int tid = ltid(), G = gridDim.x, bx = blockIdx.x;
    const int vcu = (G % 8 == 0) ? (bx % 8) * (G / 8) + bx / 8 : bx;
    for (int u = tid; u < LDS_MISC / 4; u += 512) ((LAS unsigned*)(lds + LDS_STAGE))[u] = 0u;
    __syncthreads();
    XcdBarrier bar; bar.bar = (unsigned*)(P.ws + WS_CTL) + CW_BAR; bar.x = 0; bar.st = nullptr;
#if !MK_PER_PHASE
    bar = xcd_barrier_post((unsigned*)(P.ws + WS_CTL) + CW_BAR, (volatile LAS unsigned*)(lds + LDS_STAGE));
#endif
    const int lo = P.ph_lo, hi = P.ph_hi;
#ifndef MK_MASK
#define MK_MASK 0xFFFFFFFFu
#endif
#define IN(k) (lo <= (k) && (k) < hi && ((MK_MASK >> ((k) == 0 ? 0 : 1 + ((k) - 1) % 13)) & 1u))
#ifndef MK_DUP
#define MK_DUP 0u
#endif
#define REPL(c) for (int rep_ = 0; rep_ < (IN(pb + (c)) ? 1 + (int)((MK_DUP >> (1 + (c))) & 1u) : 0); ++rep_) if ((rep_ == 0) || (xcd_barrier(bar), true))
#if MK_PER_PHASE
#define SEAM(k) do { } while (0)
#else
#define SEAM(k) do { if (IN(k) && IN((k) + 1)) xcd_barrier(bar); } while (0)
#endif
    for (int rep_ = 0; rep_ < (IN(0) ? 1 + (int)(MK_DUP & 1u) : 0); ++rep_) { if (rep_) xcd_barrier(bar); ph_prologue(P, lds); } SEAM(0);
#pragma unroll 1
    for (int l = 0; l < 2; ++l) {
        const int pb = 1 + 13 * l;
        const int Mq = (l == 0) ? MT : TX;
        REPL(0) { if (l == 0) ph_norm_in(P, MT); } SEAM(pb + 0);
        REPL(1) {
            { unsigned char* ws = lptr(P.ws); const unsigned char* wl = ws + WS_W + (size_t)l * WL_SIZE;
              pg8::Gemm g{(const bf16_t*)(ws + WS_H8), (const bf16_t*)(wl + WL_IN8), D, D, D};
              pg8::GridOrderDeal S; if (l == 0) S.init(MT / 256, INCP / 256 - (F8_HI - F8_LO), G, bx, 0, 1, F8_LO, F8_HI - F8_LO); else S.init(TX / 256, INCP / 256 - (F8_HI - F8_LO), G, bx, TC / 256, 4, F8_LO, F8_HI - F8_LO);
              { const int tot = S.nwg + S.extra; S.deal(tot / G, tot % G, 0);
                if (G == 256) { if (l == 0) S.deal(8, 140, 56); else S.deal(7, 192, 144); } }
              pg8::EpiP8 E{(bf16_t*)(ws + WS_P), INCP, 1.0f / (S8_H * S8_W)};
              pg8::gemm_phase8<pg8::EpiP8, pg8::GridOrderDeal>(lds, g, S, E); }
            { unsigned char* ws = lptr(P.ws); const unsigned char* wl = ws + WS_W + (size_t)l * WL_SIZE;
              pg8::Gemm g{(const bf16_t*)(ws + WS_H), (const bf16_t*)(wl + WL_IN), D, D, D};
              pg8::GridOrder S; S.init((l == 0 ? MT : TX) / 256, F8_HI - F8_LO, G, G - 1 - bx, 0, 1, 0, F8_LO);
              pg8::EpiBf16G E{(bf16_t*)(ws + WS_P), INCP, 1.0f};
              pg8::gemm_phase<pg8::EpiBf16G, pg8::GridOrder>(lds, g, S, E); }
            if (l == 0) { const int nun = (MT / 256) * (INCP / 256), n13 = nun - (nun / G) * G;
                if (n13 > 0 && bx >= n13) { const int nconv = G - n13; const int wend = P.tiles_l0 + nconv * CVT_A1; cvt_tiles(P, lds, P.tiles_l0 + (bx - n13), nconv, wend < P.total_tiles ? wend : P.total_tiles); } }
        } SEAM(pb + 1);
        REPL(2) { ph_post_in(P, l, Mq, lds); } SEAM(pb + 2);
        REPL(3) {
#pragma unroll 1
            for (int q = 0; q < 2; ++q) {
                unsigned char* ws = lptr(P.ws); const unsigned char* wl = ws + WS_W + (size_t)l * WL_SIZE;
                pg8::Gemm g{(const bf16_t*)(ws + (q ? WS_CQN : WS_CKVN)), (const bf16_t*)(wl + (q ? WL_UQ : WL_UKV)), q ? 512 : 256, q ? 512 : 256, q ? 512 : 256};
                pg8::GridOrder S; S.init((q ? Mq : MT) / 256, q ? 6 : 8, G, q ? G - 1 - bx : bx);
                pg8::EpiBf16 E{(bf16_t*)(ws + (q ? WS_QUP : WS_KVUP)), q ? 1536 : 2048, 1.0f / (S8_H * S8_WU)};
                pg8::gemm_phase8<pg8::EpiBf16, pg8::GridOrder>(lds, g, S, E);
            }
        } SEAM(pb + 3);
        REPL(4) { ph_post_up(P, l, Mq, lds); } SEAM(pb + 4);
        REPL(5) { ph_attention(P, l, (char*)shm, vcu); } SEAM(pb + 5);
        REPL(6) {
#pragma unroll 1
            for (int q = 0; q < 2; ++q) { const int br = q * 2;
                unsigned char* ws = lptr(P.ws); const unsigned char* wl = ws + WS_W + (size_t)l * WL_SIZE;
                pg8::Gemm g{(const bf16_t*)(ws + WS_YCAT + (size_t)br * MT * 1024 * 2), (const bf16_t*)(wl + WL_OA + (size_t)br * 2048 * 1024 * 2), 1024, 1024, 1024};
                pg8::GridOrder S; S.init(Mq / 256, 8, G, bx);
                pg8::EpiGate E{(bf16_t*)(ws + WS_M), (const unsigned char*)(ws + WS_P) + G8_OFF + br * D, INCP * 2, P.in[I_BGATE] + (size_t)l * 3 * D + br * D, q > 0, 1.0f / (S8_Y * S8_W)};
                pg8::gemm_phase8<pg8::EpiGate, pg8::GridOrder>(lds, g, S, E);
            }
            {   unsigned char* ws = lptr(P.ws); const unsigned char* wl = ws + WS_W + (size_t)l * WL_SIZE;
                pg8::Gemm g{(const bf16_t*)(ws + WS_YCAT) + (size_t)MT * 1024, (const bf16_t*)(wl + WL_OB), 1024, 1024, 1024};
                pg8::GridOrder S; S.init(Mq / 256, 8, G, bx);
                pg8::EpiGate E{(bf16_t*)(ws + WS_M), (const unsigned char*)(ws + WS_P) + G8_OFF + D, INCP * 2, P.in[I_BGATE] + (size_t)l * 3 * D + D, true, 1.0f};
                pg8::gemm_phase<pg8::EpiGate, pg8::GridOrder>(lds, g, S, E);
            }
            if (l == 0) { const int n3 = (Mq / 256) * 8 - 2 * G;
                if (n3 > 0 && n3 < G && bx >= n3) { const int nconv = G - n3, w0 = P.tiles_l0 + CVT_A1_TOTAL, wsplit = w0 + nconv * CVT_A6; cvt_tiles(P, lds, w0 + (bx - n3), nconv, wsplit < P.total_tiles ? wsplit : P.total_tiles); } }
        } SEAM(pb + 6);
        REPL(7) {
            unsigned char* ws = lptr(P.ws); const unsigned char* wl = ws + WS_W + (size_t)l * WL_SIZE;
            const float* modv = (const float*)(ws + WS_MODV) + (size_t)l * 5 * 12288;
            pg8::Gemm g{(const bf16_t*)(ws + WS_M), (const bf16_t*)(wl + WL_O), D, D, D};
            pg8::GridOrder S; S.init(Mq / 256, 8, G, bx);
            pg8::EpiResid E{P.in[I_X], P.in[I_CTX] - (size_t)TX * D, (l == 0) ? (const bf16_t*)nullptr : (const bf16_t*)(ws + WS_X2), (bf16_t*)(ws + WS_X1), modv + 4096, 12288};
            pg8::gemm_phase<pg8::EpiResid, pg8::GridOrder>(lds, g, S, E);
            if (l == 0) { const int n3 = (Mq / 256) * 8 - 2 * G;
                if (n3 > 0 && n3 < G && bx >= n3) { const int nconv = G - n3, w0 = P.tiles_l0 + CVT_A1_TOTAL + nconv * CVT_A6; cvt_tiles(P, lds, w0 + (bx - n3), nconv, P.total_tiles); } }
        } SEAM(pb + 7);
        REPL(8) { ph_norm_route(P, l, Mq, lds, ((MK_DUP >> 9) & 1u) && rep_ == 0); } SEAM(pb + 8);
        REPL(10) {
            moe_tables(P, l, lds);
            unsigned char* ws = lptr(P.ws); const unsigned char* wl = ws + WS_W + (size_t)l * WL_SIZE;
            pg8::Gemm g{(const bf16_t*)(ws + WS_H8), (const bf16_t*)(wl + WL_GU), D, D, D};
            pg8::MoeOrder S{*(const LAS int*)(lds + LDS_STAGE + MISC_NBLK), 4, G, vcu, (const LAS int*)(lds + LDS_STAGE + MISC_BLKE),
                            (const LAS int*)(lds + LDS_STAGE + MISC_FBLK), (const LAS int*)(lds + LDS_STAGE + MISC_ECNT), (const int*)(ws + WS_ELIST)};
            pg8::EpiSwiglu8 E{(unsigned char*)(ws + WS_ACT), 1.0f / (S8_H * S8_W)};
            pg8::gemm_phase8<pg8::EpiSwiglu8, pg8::MoeOrder, true, true>(lds, g, S, E);
        } SEAM(pb + 10);
        REPL(11) {
            moe_tables(P, l, lds);
            unsigned char* ws = lptr(P.ws); const unsigned char* wl = ws + WS_W + (size_t)l * WL_SIZE;
            pg8::Gemm g{(const bf16_t*)(ws + WS_ACT), (const bf16_t*)(wl + WL_DN), DE, DE, DE};
            pg8::MoeOrder S{*(const LAS int*)(lds + LDS_STAGE + MISC_NBLK), 8, G, vcu, (const LAS int*)(lds + LDS_STAGE + MISC_BLKE), nullptr, nullptr, nullptr};
            pg8::EpiBf16Moe E{(bf16_t*)(ws + WS_YS), D, 8, 1.0f / (S8_ACT * S8_WD)};
            pg8::gemm_phase8<pg8::EpiBf16Moe, pg8::MoeOrder>(lds, g, S, E);
        } SEAM(pb + 11);
        REPL(12) { ph_combine(P, l, Mq, lds); } if (l == 0) SEAM(pb + 12);
#ifdef MK_XBAR
        if (l == 1) { for (int q = 0; q < MK_XBAR; ++q) xcd_barrier(bar); }
#endif
    }
#undef IN
#undef SEAM
}


#if MK_CHECK
constexpr size_t CW_CHK = 8192;
__device__ __forceinline__ unsigned hash32(unsigned x) { x ^= x >> 16; x *= 0x7feb352dU; x ^= x >> 15; x *= 0x846ca68bU; x ^= x >> 16; return x; }
__device__ __forceinline__ float dotbf(const bf16_t* a, const bf16_t* b, int K) { float s = 0.f; for (int k = 0; k < K; ++k) s += bf2f(a[k]) * bf2f(b[k]); return s; }
__device__ __forceinline__ void chk_report(unsigned* cnt, int id, float got, float ref, float scale) {
    const float err = fabsf(got - ref), tol = 0.03f * fabsf(ref) + 0.03f * scale;
    if (!(err <= tol)) atomicAdd(cnt + id, 1u);
}
__global__ void __launch_bounds__(256) chk_kernel(Params P, int l, int kind, int id) {
    unsigned char* ws = P.ws; unsigned* cnt = (unsigned*)(ws + WS_CTL) + CW_CHK;
    const unsigned char* wl = ws + WS_W + (size_t)l * WL_SIZE;
    const int Mq = (l == 0) ? MT : TX;
    const unsigned t = blockIdx.x * 256 + threadIdx.x; const unsigned h1 = hash32(t * 2 + 1), h2 = hash32(t * 2 + 2 + 0x9e3779b9u);
    if (kind == 0) { const int row = h1 % MT, col = h2 % ((l == 1 && row >= TX) ? 832 : INC);
        const float ref = dotbf((const bf16_t*)(ws + WS_H) + (size_t)row * D, (const bf16_t*)(wl + WL_IN) + (size_t)col * D, D);
        chk_report(cnt, id, bf2f(((const bf16_t*)(ws + WS_P))[(size_t)row * INCP + col]), ref, 1.f); }
    if (kind == 1) { const int row = h1 % MT, col = h2 % 2048;
        const float ref = dotbf((const bf16_t*)(ws + WS_CKVN) + (size_t)row * 256, (const bf16_t*)(wl + WL_UKV) + (size_t)col * 256, 256);
        chk_report(cnt, id, bf2f(((const bf16_t*)(ws + WS_KVUP))[(size_t)row * 2048 + col]), ref, 1.f); }
    if (kind == 2) { const int row = h1 % Mq, col = h2 % 1536;
        const float ref = dotbf((const bf16_t*)(ws + WS_CQN) + (size_t)row * 512, (const bf16_t*)(wl + WL_UQ) + (size_t)col * 512, 512);
        chk_report(cnt, id, bf2f(((const bf16_t*)(ws + WS_QUP))[(size_t)row * 1536 + col]), ref, 1.f); }
    if (kind == 3) { const int row = h1 % Mq, col = h2 % D; float m = 0.f;
        for (int br = 0; br < 3; ++br) { const float d = dotbf((const bf16_t*)(ws + WS_YCAT) + ((size_t)br * MT + row) * 1024, (const bf16_t*)(wl + WL_OA) + ((size_t)br * 2048 + col) * 1024, 1024);
            const float gl = bf2f(((const bf16_t*)(ws + WS_P))[(size_t)row * INCP + C_GL + br * D + col]) + P.in[I_BGATE][(size_t)l * 3 * D + br * D + col];
            m += d / (1.f + expf(-gl)); }
        chk_report(cnt, id, bf2f(((const bf16_t*)(ws + WS_M))[(size_t)row * D + col]), m, 1.f); }
    if (kind == 4) { const int row = h1 % Mq, col = h2 % D;
        const float d = dotbf((const bf16_t*)(ws + WS_M) + (size_t)row * D, (const bf16_t*)(wl + WL_O) + (size_t)col * D, D);
        const float xi = (l == 0) ? ((row < TX) ? P.in[I_X][(size_t)row * D + col] : P.in[I_CTX][(size_t)(row - TX) * D + col]) : ((const float*)(ws + WS_X2))[(size_t)row * D + col];
        const float g1 = ((const float*)(ws + WS_MODV))[((size_t)l * 5 + row_rb(row)) * 12288 + 4096 + col];
        chk_report(cnt, id, ((const float*)(ws + WS_X1))[(size_t)row * D + col], xi + g1 * d, 1.f); }
    if (kind == 5 || kind == 6) {
        const int a = h1 % (Mq * 2); const int e = ((const int*)(ws + WS_RTE))[a], slot = ((const int*)(ws + WS_RTS))[a], r = a >> 1;
        if (kind == 5) { const int col = h2 % DE;
            const bf16_t hx = ((const bf16_t*)(ws + WS_H))[(size_t)r * D + (h2 % D)], xx = ((const bf16_t*)(ws + WS_XS))[(size_t)slot * D + (h2 % D)];
            if (hx != xx) atomicAdd(cnt + id, 1u);
            const float* wg = P.in[I_WGU] + ((size_t)l * NE + e) * D * 1024; float g = 0.f, u = 0.f;
            for (int k = 0; k < D; ++k) { const float x = bf2f(((const bf16_t*)(ws + WS_XS))[(size_t)slot * D + k]); g += x * wg[(size_t)k * 1024 + col]; u += x * wg[(size_t)k * 1024 + DE + col]; }
            chk_report(cnt, id, bf2f(((const bf16_t*)(ws + WS_ACT))[(size_t)slot * DE + col]), g / (1.f + expf(-g)) * u, 1.f); }
        else { const int col = h2 % D; const float* wd = P.in[I_WDOWN] + ((size_t)l * NE + e) * DE * D; float y = 0.f;
            for (int k = 0; k < DE; ++k) y += bf2f(((const bf16_t*)(ws + WS_ACT))[(size_t)slot * DE + k]) * wd[(size_t)k * D + col];
            chk_report(cnt, id, bf2f(((const bf16_t*)(ws + WS_YS))[(size_t)slot * D + col]), y, 1.f); } }
    if (kind == 7) { const int row = h1 % Mq, c = h2 % 1024; const bf16_t* Pb = (const bf16_t*)(ws + WS_P);
        const bool isx = row < TX; const int s_ = isx ? (row & (SEQ - 1)) : ((row - TX) & (CL - 1)); const int slen = isx ? SEQ : CL;
        const float* cw = P.in[I_CONVW] + (size_t)l * 3 * 1024;
        auto z = [&](int rr) { return bf2f(Pb[(size_t)rr * INCP + C_XB + c]) * bf2f(Pb[(size_t)rr * INCP + C_GC + c]); };
        float acc = cw[1024 + c] * z(row); if (s_ > 0) acc += cw[c] * z(row - 1); if (s_ < slen - 1) acc += cw[2048 + c] * z(row + 1);
        chk_report(cnt, id, bf2f(((const bf16_t*)(ws + WS_YCAT))[((size_t)MT + row) * 1024 + c]), bf2f(Pb[(size_t)row * INCP + C_GB + c]) * acc, 1.f); }
    const float* modv_all = (const float*)(ws + WS_MODV);
    if (kind == 8) { const int r = h1 % 5, j = h2 % 12288; float acc = 0.f;
        for (int k = 0; k < D; ++k) { const float v = (r < 4) ? P.in[I_C][r * D + k] : P.in[I_CCTX][k]; acc += v / (1.f + expf(-v)) * P.in[I_WMOD][((size_t)l * D + k) * 12288 + j]; }
        chk_report(cnt, id, modv_all[((size_t)l * 5 + r) * 12288 + j], acc + P.in[I_BMOD][l * 12288 + j], 0.3f); }
    if (kind == 9) {
        const int row = h1 % MT, col = h2 % D; const float* xr = (l == 0) ? ((row < TX) ? P.in[I_X] + (size_t)row * D : P.in[I_CTX] + (size_t)(row - TX) * D) : (const float*)(ws + WS_X2) + (size_t)row * D;
        float ss = 0.f; for (int k = 0; k < D; ++k) ss += xr[k] * xr[k];
        const float* mv = modv_all + ((size_t)l * 5 + row_rb(row)) * 12288;
        const float ref = xr[col] / sqrtf(ss / D + EPS) * P.in[I_NORM1][l * D + col] * (1.f + mv[2048 + col]) + mv[col];
        chk_report(cnt, id, bf2f(((const bf16_t*)(ws + WS_H))[(size_t)row * D + col]), ref, 1.f); }
    if (kind == 10 || kind == 12) {
        const bool mla = (kind == 12); const int row = h1 % MT; const bool isx = row < TX; const int b = isx ? (row >> 12) : ((row - TX) >> 8), s_ = isx ? (row & (SEQ - 1)) : ((row - TX) & (CL - 1));
        const int key = isx ? CL + s_ : s_, qrow = isx ? s_ : SEQ + s_; const int HD_ = mla ? 192 : 128;
        const bool isq = ((h2 >> 20) & 1) && row < Mq; const int nh = (isq || mla) ? 8 : 2; const int hh = (h2 >> 8) % nh, d = (h2 & 255) % HD_;
        const bf16_t* Pb = (const bf16_t*)(ws + WS_P) + (size_t)row * INCP;
        auto getv = [&](int i) -> float {
            if (!mla) return bf2f(Pb[(isq ? C_Q : C_K) + hh * 128 + i]);
            if (isq) return bf2f(((const bf16_t*)(ws + WS_QUP))[(size_t)row * 1536 + hh * 192 + i]);
            return (i < 128) ? bf2f(((const bf16_t*)(ws + WS_KVUP))[(size_t)row * 2048 + hh * 256 + i]) : bf2f(Pb[C_KR + i - 128]); };
        float ss = 0.f; for (int i = 0; i < HD_; ++i) { const float x = getv(i); ss += x * x; }
        const float rs = 1.f / sqrtf(ss / HD_ + EPS);
        const float* gn = mla ? (isq ? P.in[I_MQN] : P.in[I_MKN]) + l * 192 : (isq ? P.in[I_GQN] : P.in[I_GKN]) + l * 128;
        float ref = getv(d) * rs * gn[d];
        const int r0 = mla ? 128 : 0, half = mla ? 32 : 64, nq = mla ? 16 : 32;
        if (isx && d >= r0) { const int i = (d - r0) % half; const bool second = (d - r0) >= half; const float pos = (i < nq) ? (float)(s_ >> 6) : (float)(s_ & 63);
            const float ang = pos * powf(10000.0f, -(float)(i % nq) / (float)nq); const float cs = cosf(ang), sn = sinf(ang);
            const float y1 = getv(r0 + i) * rs * gn[r0 + i], y2 = getv(r0 + half + i) * rs * gn[r0 + half + i]; ref = second ? (y2 * cs + y1 * sn) : (y1 * cs - y2 * sn); }
        float got;
        if (!mla) got = isq ? bf2f(((const bf16_t*)(ws + WS_QA))[((size_t)(b * 8 + hh) * LKV + qrow) * 128 + d]) : bf2f(((const bf16_t*)(ws + WS_KA))[((size_t)(b * 2 + hh) * LKV + key) * 128 + d]);
        else got = isq ? bf2f(((const bf16_t*)(ws + WS_QC))[((size_t)(b * 8 + hh) * LKV + qrow) * 192 + d]) : bf2f(((const bf16_t*)(ws + WS_KC))[((size_t)(b * 8 + hh) * LKV + key) * 192 + d]);
        chk_report(cnt, id, got, ref, 1.f);
        if (mla && !isq && d < 128) {
            const bf16_t a = ((const bf16_t*)(ws + WS_KVUP))[(size_t)row * 2048 + hh * 256 + 128 + d], c2 = ((const bf16_t*)(ws + WS_VC))[((size_t)(b * 8 + hh) * LKV + key) * 128 + d]; if (a != c2) atomicAdd(cnt + id, 1u); }
        if (!mla && !isq) { const bf16_t a = Pb[C_V + hh * 128 + d], c2 = ((const bf16_t*)(ws + WS_VA))[((size_t)(b * 2 + hh) * LKV + key) * 128 + d]; if (a != c2) atomicAdd(cnt + id, 1u); } }
    if (kind == 11) {
        const int row = h1 % Mq; const bool q = (h2 >> 20) & 1; const int n = q ? 512 : 256, c0 = q ? C_CQ : C_CKV, d = (h2 & 0xffff) % n; const bf16_t* Pb = (const bf16_t*)(ws + WS_P) + (size_t)row * INCP;
        float ss = 0.f; for (int i = 0; i < n; ++i) { const float x = bf2f(Pb[c0 + i]); ss += x * x; }
        const float ref = bf2f(Pb[c0 + d]) / sqrtf(ss / n + EPS) * (q ? P.in[I_MQLN][l * 512 + d] : P.in[I_MKVLN][l * 256 + d]);
        chk_report(cnt, id, q ? bf2f(((const bf16_t*)(ws + WS_CQN))[(size_t)row * 512 + d]) : bf2f(((const bf16_t*)(ws + WS_CKVN))[(size_t)row * 256 + d]), ref, 1.f); }
    if (kind == 13 || kind == 14) {
        const bool mla = (kind == 14); const int row = h1 % Mq; const bool isx = row < TX; const int b = isx ? (row >> 12) : ((row - TX) >> 8), s_ = isx ? (row & (SEQ - 1)) : ((row - TX) & (CL - 1));
        const int qrow = isx ? s_ : SEQ + s_, nk = isx ? LKV : CL, hh = (h2 >> 8) & 7, d = h2 & 127, HD_ = mla ? 192 : 128;
        const bf16_t* q = mla ? (const bf16_t*)(ws + WS_QC) + ((size_t)(b * 8 + hh) * LKV + qrow) * 192 : (const bf16_t*)(ws + WS_QA) + ((size_t)(b * 8 + hh) * LKV + qrow) * 128;
        const bf16_t* kb = mla ? (const bf16_t*)(ws + WS_KC) + (size_t)(b * 8 + hh) * LKV * 192 : (const bf16_t*)(ws + WS_KA) + (size_t)(b * 2 + (hh >> 2)) * LKV * 128;
        const bf16_t* vb = mla ? (const bf16_t*)(ws + WS_VC) + (size_t)(b * 8 + hh) * LKV * 128 : (const bf16_t*)(ws + WS_VA) + (size_t)(b * 2 + (hh >> 2)) * LKV * 128;
        const float sc = 1.0f / sqrtf((float)HD_); float mx = -1e30f, den = 0.f, num = 0.f;
        for (int k = 0; k < nk; ++k) { const float sv = dotbf(q, kb + (size_t)k * HD_, HD_) * sc; if (sv > mx) { const float f = expf(mx - sv); den *= f; num *= f; mx = sv; }
            const float p = expf(sv - mx); den += p; num += p * bf2f(vb[(size_t)k * 128 + d]); }
        const float got = bf2f(((const bf16_t*)(ws + WS_YCAT))[((size_t)(mla ? 2 : 0) * MT + row) * 1024 + hh * 128 + d]);
        chk_report(cnt, id, got, num / den, 0.05f); }
    if (kind == 15) {
        const int row = h1 % Mq; const float* xr = (const float*)(ws + WS_X1) + (size_t)row * D; const int col = h2 % D;
        float ss = 0.f; for (int k = 0; k < D; ++k) ss += xr[k] * xr[k];
        const float rs = 1.f / sqrtf(ss / D + EPS); const float* mv = modv_all + ((size_t)l * 5 + row_rb(row)) * 12288; const float* gn = P.in[I_NORM2] + l * D;
        chk_report(cnt, id, bf2f(((const bf16_t*)(ws + WS_H))[(size_t)row * D + col]), xr[col] * rs * gn[col] * (1.f + mv[8192 + col]) + mv[6144 + col], 1.f);
        float g4[4];
#pragma unroll
        for (int o = 0; o < 4; ++o) g4[o] = P.in[I_BGROUP][l * 4 + o];
        for (int k = 0; k < D; ++k) { const float hv = xr[k] * rs * gn[k] * (1.f + mv[8192 + k]) + mv[6144 + k];
#pragma unroll
            for (int o = 0; o < 4; ++o) g4[o] += hv * P.in[I_WGROUP][((size_t)l * D + k) * 4 + o]; }
        int gi = 0; float gb = g4[0];
#pragma unroll
        for (int o = 1; o < 4; ++o) if (g4[o] > gb) { gb = g4[o]; gi = o; }
        float den = 0.f;
#pragma unroll
        for (int o = 0; o < 4; ++o) den += expf(g4[o] - gb);
        float e8[8];
#pragma unroll
        for (int j = 0; j < 8; ++j) e8[j] = P.in[I_BROUTER][l * 32 + gi * 8 + j];
        for (int k = 0; k < D; ++k) { const float hv = xr[k] * rs * gn[k] * (1.f + mv[8192 + k]) + mv[6144 + k];
#pragma unroll
            for (int j = 0; j < 8; ++j) e8[j] += hv * P.in[I_WROUTER][((size_t)l * D + k) * NE + gi * 8 + j]; }
        int i0 = 0; float v0 = e8[0];
#pragma unroll
        for (int j = 1; j < 8; ++j) if (e8[j] > v0) { v0 = e8[j]; i0 = j; }
        int i1 = -1; float v1 = -3.0e38f;
#pragma unroll
        for (int j = 0; j < 8; ++j) if (j != i0 && e8[j] > v1) { v1 = e8[j]; i1 = j; }
        const float e1 = expf(v1 - v0); const float w0 = 1.f / (1.f + e1) / den, w1 = e1 / (1.f + e1) / den;
        const int* rte = (const int*)(ws + WS_RTE); const float* rtw = (const float*)(ws + WS_RTW);
        if (rte[row * 2] != gi * 8 + i0) atomicAdd(cnt + id + 4, 1u); else if (rte[row * 2 + 1] != gi * 8 + i1) atomicAdd(cnt + id + 5, 1u);
        else { chk_report(cnt, id + 6, rtw[row * 2], w0, 0.05f); chk_report(cnt, id + 6, rtw[row * 2 + 1], w1, 0.05f); } }
    if (kind == 16) {
        const int row = h1 % Mq, col = h2 % D; const int* rts = (const int*)(ws + WS_RTS); const float* rtw = (const float*)(ws + WS_RTW); const bf16_t* YS = (const bf16_t*)(ws + WS_YS);
        const float g2 = modv_all[((size_t)l * 5 + row_rb(row)) * 12288 + 10240 + col];
        const float ref = ((const float*)(ws + WS_X1))[(size_t)row * D + col] + g2 * (rtw[row * 2] * bf2f(YS[(size_t)rts[row * 2] * D + col]) + rtw[row * 2 + 1] * bf2f(YS[(size_t)rts[row * 2 + 1] * D + col]));
        const float got = (l == 1) ? P.out[(size_t)row * D + col] : ((const float*)(ws + WS_X2))[(size_t)row * D + col];
        chk_report(cnt, id, got, ref, 1.f); }
}
__global__ void chk_final(Params P) {
    const unsigned* cnt = (const unsigned*)(P.ws + WS_CTL) + CW_CHK; int bad = 0;
    for (int i = 1; i < 64; ++i) if (cnt[i] != 0u) { bad = i; break; }
    if (bad) { float v = 1024.f; for (int i = 0; i < bad; ++i) v *= 2.f; for (size_t i = (size_t)blockIdx.x * 256 + threadIdx.x; i < (size_t)TX * D; i += (size_t)gridDim.x * 256) P.out[i] = v; }
}
#endif

extern "C" void kernel_launch(void* const* d_in, const int* in_sizes, int n_in, void* d_out, int out_size, void* d_ws, size_t ws_size, hipStream_t stream) {
    static int grid = 0;
    if (grid == 0) {
        if (n_in != 29 || in_sizes[0] != TX * D || out_size != TX * D || ws_size < WS_END) {
            fprintf(stderr, "kernel_launch: shape mismatch: n_in %d in0 %d out %d ws %zu (need %zu)\n", n_in, n_in > 0 ? in_sizes[0] : -1, out_size, ws_size, (size_t)WS_END); grid = -1; return; }
        int dev = 0, cus = 0, per_cu = 0;
        if (hipGetDevice(&dev) != hipSuccess || hipDeviceGetAttribute(&cus, hipDeviceAttributeMultiprocessorCount, dev) != hipSuccess) { grid = -1; return; }
        if (hipFuncSetAttribute((const void*)mk_fwd, hipFuncAttributeMaxDynamicSharedMemorySize, LDS_BYTES) != hipSuccess) { fprintf(stderr, "kernel_launch: hipFuncSetAttribute failed\n"); grid = -1; return; }
        if (hipOccupancyMaxActiveBlocksPerMultiprocessor(&per_cu, (const void*)mk_fwd, 512, LDS_BYTES) != hipSuccess || per_cu < 1) {
            fprintf(stderr, "kernel_launch: occupancy query says %d blocks per CU\n", per_cu); (void)hipGetLastError(); grid = -1; return; }
        grid = cus;
    }
    if (grid < 0) return;
    (void)hipMemsetAsync((char*)d_ws + WS_CTL, 0, CTL_BYTES, stream);
    Params p{};
    for (int i = 0; i < 29; ++i) p.in[i] = (const float*)d_in[i];
    p.out = (float*)d_out; p.ws = (unsigned char*)d_ws;
    {
        int nj = 0, t0 = 0;
        auto add = [&](const float* src, size_t dst_off, int K, int N, int Npad, int batch, int mode, float scale = 1.f, int ld = 0) {
            CvtJob& j = p.jobs[nj++]; j.src = src; j.dst = (bf16_t*)((unsigned char*)d_ws + dst_off); j.K = K; j.N = N; j.Npad = Npad; j.batch = batch; j.mode = mode; j.tile0 = t0; j.scale = scale; j.ld = ld ? ld : N;
            t0 += batch * (K / 128) * (Npad / 128); };
        for (int l = 0; l < 2; ++l) {
            const size_t wl = WS_W + (size_t)l * WL_SIZE;
            add(p.in[I_WGU] + (size_t)l * NE * D * 1024, wl + WL_GU, D, 1024, 1024, NE, 3, S8_W);
            add(p.in[I_WDOWN] + (size_t)l * NE * DE * D, wl + WL_DN, DE, D, D, NE, 2, S8_WD);
            add(p.in[I_WIN] + (size_t)l * D * INC + F8_LO * 256, wl + WL_IN + (size_t)F8_LO * 256 * D * 2, D, (F8_HI - F8_LO) * 256, (F8_HI - F8_LO) * 256, 1, 0, 1.f, INC);
            add(p.in[I_WIN] + (size_t)l * D * INC, wl + WL_IN8, D, F8_LO * 256, F8_LO * 256, 1, 2, S8_W, INC);
            add(p.in[I_WIN] + (size_t)l * D * INC + F8_HI * 256, wl + WL_IN8 + (size_t)F8_HI * 256 * D, D, INC - F8_HI * 256, INCP - F8_HI * 256, 1, 2, S8_W, INC);
            add(p.in[I_WO] + (size_t)l * D * D, wl + WL_O, D, D, D, 1, 0);
            add(p.in[I_WOA] + (size_t)l * 1024 * D, wl + WL_OA, 1024, D, D, 1, 2, S8_W);
            add(p.in[I_WOB] + (size_t)l * 1024 * D, wl + WL_OB, 1024, D, D, 1, 0);
            add(p.in[I_WOC] + (size_t)l * 1024 * D, wl + WL_OC, 1024, D, D, 1, 2, S8_W);
            add(p.in[I_WUQ] + (size_t)l * 512 * 1536, wl + WL_UQ, 512, 1536, 1536, 1, 2, S8_WU);
            add(p.in[I_WUKV] + (size_t)l * 256 * 2048, wl + WL_UKV, 256, 2048, 2048, 1, 2, S8_WU);
        }
        p.total_tiles = t0; p.tiles_l0 = p.jobs[11].tile0;
    }
#if MK_PER_PHASE
    for (int k = 0; k < NPH; ++k) { if (k == 14) continue; p.ph_lo = k; p.ph_hi = k + 1; hipLaunchKernelGGL(mk_fwd, dim3(grid), dim3(512), LDS_BYTES, stream, p);
#if MK_CHECK
        { const int l = (k == 0) ? 0 : (k - 1) / 13, ph = (k == 0) ? -1 : (k - 1) % 13, base = 1 + 20 * l;
            auto C = [&](int ll, int kind, int id) { hipLaunchKernelGGL(chk_kernel, dim3(kind == 13 || kind == 14 || kind == 15 ? 16 : 128), dim3(256), 0, stream, p, ll, kind, id); };
            if (k == 0) { C(0, 8, 1); C(1, 8, 21); }
            if (ph == 0 && l == 0) C(0, 9, 2);
            if (ph == 1) C(l, 0, base + 2); if (ph == 2) { C(l, 7, base + 3); C(l, 10, base + 4); C(l, 11, base + 5); } if (ph == 3) { C(l, 1, base + 6); C(l, 2, base + 7); }
            if (ph == 4) C(l, 12, base + 8); if (ph == 5) { C(l, 13, base + 9); C(l, 14, base + 10); }
            if (ph == 6) C(l, 3, base + 11); if (ph == 7) C(l, 4, base + 12); if (ph == 8) C(l, 15, base + 13);
            if (ph == 10) C(l, 5, base + 14); if (ph == 11) C(l, 6, base + 15); if (ph == 12) { C(l, 16, base + 16); if (l == 0) C(1, 9, 22); } }
#endif
    }
#if MK_CHECK
    hipLaunchKernelGGL(chk_final, dim3(1024), dim3(256), 0, stream, p);
#endif
#else
    p.ph_lo = 0; p.ph_hi = NPH;
    hipLaunchKernelGGL(mk_fwd, dim3(grid), dim3(512), LDS_BYTES, stream, p);
#endif
    const hipError_t le = hipPeekAtLastError();
    if (le != hipSuccess) fprintf(stderr, "kernel_launch: launch failed: %s\n", hipGetErrorName(le));
}
```
